# Optimizing an MI355X kernel written in HIP

```python
import math
import jax
import jax.numpy as jnp
from jax import lax
import numpy as np

D_MODEL = 1024
BATCH = 4
SEQ = 8192
DEPTH = 4

GRID_W = 64
CTX_LEN = 256
EPS = 1e-6
NEG_INF = -1e30
ROPE_BASE = 10000.0
BLOCK = 128
F32 = jnp.float32

S5_CH = 256
S5_GROUP = 16
S5_GROUPS = S5_CH // S5_GROUP
S5_STATE = 64
SWA_HEADS = 4
SWA_KV_HEADS = 2
SWA_HEAD_DIM = 64
SWA_WINDOW = 128
HG_HEADS = 4
HG_DK = 64
HG_DV = 64
HG_CHUNK = 32
MLA_HEADS = 4
MLA_Q_RANK = 256
MLA_KV_RANK = 128
MLA_NOPE = 64
MLA_ROPE = 32
MLA_V = 64
MLA_SCALE = (MLA_NOPE + MLA_ROPE) ** -0.5
FFN_HIDDEN = -(-8 * D_MODEL // (3 * 256)) * 256

IN_SIZES = (
    S5_CH,
    SWA_HEADS * SWA_HEAD_DIM,
    SWA_KV_HEADS * SWA_HEAD_DIM,
    SWA_KV_HEADS * SWA_HEAD_DIM,
    HG_HEADS * HG_DK,
    HG_HEADS * HG_DK,
    HG_HEADS * HG_DK,
    HG_HEADS * HG_DV,
    HG_HEADS * HG_DV,
    MLA_Q_RANK,
    MLA_KV_RANK,
    MLA_ROPE,
)
N_IN = sum(IN_SIZES)
D_MIX = S5_CH + SWA_HEADS * SWA_HEAD_DIM + HG_HEADS * HG_DV + MLA_HEADS * MLA_V

kernel_name = 'hybrid_prefix_dit_block'


def rms_norm(x, g):
    xf = x.astype(F32)
    y = xf * lax.rsqrt(jnp.mean(xf * xf, axis=-1, keepdims=True) + EPS)
    return (y * g.astype(F32)).astype(x.dtype)


def split_cols(p):
    parts, start = [], 0
    for n in IN_SIZES:
        parts.append(p[..., start:start + n])
        start += n
    return parts


def swiglu(h, w_up, w_down):
    gate, up = jnp.split(h @ w_up, 2, axis=-1)
    return (jax.nn.silu(gate) * up) @ w_down


def axial_rope_tables(length, dim):
    rows = length // GRID_W
    row = jnp.repeat(jnp.arange(rows, dtype=F32), GRID_W)
    col = jnp.tile(jnp.arange(GRID_W, dtype=F32), rows)
    n_freq = dim // 4
    inv = ROPE_BASE ** (-jnp.arange(n_freq, dtype=F32) / n_freq)
    ang = jnp.stack([row[:, None] * inv, col[:, None] * inv], axis=1)
    return jnp.cos(ang), jnp.sin(ang)


def apply_axial_rope(x, cos, sin):
    b, l, h, dim = x.shape
    xr = x.astype(F32).reshape(b, l, h, 2, 2, dim // 4)
    x1, x2 = xr[..., 0, :], xr[..., 1, :]
    c = cos[None, :, None]
    s = sin[None, :, None]
    out = jnp.stack([x1 * c - x2 * s, x2 * c + x1 * s], axis=-2)
    return out.reshape(b, l, h, dim).astype(x.dtype)


def s5_linear_scan(a_bar, bu, s0):
    bu = bu.at[:, 0].add(a_bar * s0)
    a = jnp.broadcast_to(a_bar, bu.shape)

    def combine(e1, e2):
        a1, b1 = e1
        a2, b2 = e2
        return a1 * a2, a2 * b1 + b2

    _, states = lax.associative_scan(combine, (a, bu), axis=1)
    return states


def s5_mixer(u, uc, lam_re, lam_im, log_dt, b_re, b_im, c_re, c_im, d_skip, w_glu, b_glu, need_ctx):
    lam = lax.complex(lam_re.astype(F32), lam_im.astype(F32))
    a_bar = jnp.exp(lam * jnp.exp(log_dt.astype(F32)))
    b_bar = ((a_bar - 1.0) / lam)[..., None] * lax.complex(b_re.astype(F32), b_im.astype(F32))
    c_mat = lax.complex(c_re.astype(F32), c_im.astype(F32))
    d_g = d_skip.astype(F32).reshape(S5_GROUPS, S5_GROUP)

    def grouped(t):
        return t.astype(F32).reshape(t.shape[0], t.shape[1], S5_GROUPS, S5_GROUP)

    def drive(ug, k):
        return jnp.einsum('btgh,gph->btgp', ug.astype(jnp.complex64), b_bar[k])

    def readout(s_f, s_b, ug):
        y = jnp.real(jnp.einsum('btgp,ghp->btgh', s_f, c_mat[0])
                     + jnp.einsum('btgp,ghp->btgh', s_b, c_mat[1])) + d_g * ug
        y = jax.nn.gelu(y.reshape(y.shape[0], y.shape[1], S5_CH))
        return y * jax.nn.sigmoid(y @ w_glu.astype(F32) + b_glu.astype(F32))

    ug, ucg = grouped(u), grouped(uc)
    zero = jnp.zeros((u.shape[0], S5_GROUPS, S5_STATE), jnp.complex64)
    sc_f = s5_linear_scan(a_bar[0], drive(ucg, 0), zero)
    sc_b = jnp.flip(s5_linear_scan(a_bar[1], jnp.flip(drive(ucg, 1), 1), zero), 1)
    sx_f = s5_linear_scan(a_bar[0], drive(ug, 0), sc_f[:, -1])
    sx_b = jnp.flip(s5_linear_scan(a_bar[1], jnp.flip(drive(ug, 1), 1), sc_b[:, 0]), 1)
    y = readout(sx_f, sx_b, ug).astype(u.dtype)
    y_c = readout(sc_f, sc_b, ucg).astype(u.dtype) if need_ctx else None
    return y, y_c


def softmax_with_sink(logits, sink):
    full = jnp.concatenate([logits, jnp.broadcast_to(sink, logits.shape[:-1] + (1,))], axis=-1)
    return jax.nn.softmax(full, axis=-1)[..., :-1]


def window_attention(q, k, v, kc, vc, sink):
    b, l, hq, dh = q.shape
    hkv = k.shape[2]
    grp = hq // hkv
    nb = l // BLOCK
    scale = dh ** -0.5
    qb = q.reshape(b, nb, BLOCK, hkv, grp, dh)

    def band(t):
        tp = jnp.pad(t, ((0, 0), (BLOCK, BLOCK), (0, 0), (0, 0))).reshape(b, nb + 2, BLOCK, hkv, dh)
        return jnp.concatenate([tp[:, :-2], tp[:, 1:-1], tp[:, 2:]], axis=2)

    kw, vw = band(k), band(v)
    qpos = jnp.arange(l).reshape(nb, BLOCK)
    kpos = (jnp.arange(nb) * BLOCK - BLOCK)[:, None] + jnp.arange(3 * BLOCK)[None, :]
    valid = ((jnp.abs(qpos[:, :, None] - kpos[:, None, :]) <= SWA_WINDOW)
             & (kpos >= 0)[:, None, :] & (kpos < l)[:, None, :])
    s_win = jnp.einsum('bnqhgd,bnkhd->bnhgqk', qb, kw).astype(F32) * scale
    s_win = jnp.where(valid[None, :, None, None], s_win, NEG_INF)
    s_ctx = jnp.einsum('bnqhgd,bchd->bnhgqc', qb, kc).astype(F32) * scale
    sink_b = sink.astype(F32).reshape(hkv, grp)[:, :, None, None]
    p = softmax_with_sink(jnp.concatenate([s_win, s_ctx], axis=-1), sink_b).astype(v.dtype)
    o = (jnp.einsum('bnhgqk,bnkhd->bnqhgd', p[..., :3 * BLOCK], vw)
         + jnp.einsum('bnhgqc,bchd->bnqhgd', p[..., 3 * BLOCK:], vc))
    return o.reshape(b, l, hq * dh)


def context_gqa(qc, kc, vc, sink):
    b, lc, hq, dh = qc.shape
    hkv = kc.shape[2]
    grp = hq // hkv
    qg = qc.reshape(b, lc, hkv, grp, dh)
    s = jnp.einsum('bqhgd,bkhd->bhgqk', qg, kc).astype(F32) * dh ** -0.5
    p = softmax_with_sink(s, sink.astype(F32).reshape(hkv, grp)[:, :, None, None]).astype(vc.dtype)
    return jnp.einsum('bhgqk,bkhd->bqhgd', p, vc).reshape(b, lc, hq * dh)


def swa_mixer(q, k, v, qc, kc, vc, sink, rope, need_ctx):
    b, l, _ = q.shape
    lc = kc.shape[1]
    q = apply_axial_rope(q.reshape(b, l, SWA_HEADS, SWA_HEAD_DIM), *rope)
    k = apply_axial_rope(k.reshape(b, l, SWA_KV_HEADS, SWA_HEAD_DIM), *rope)
    v = v.reshape(b, l, SWA_KV_HEADS, SWA_HEAD_DIM)
    kc = kc.reshape(b, lc, SWA_KV_HEADS, SWA_HEAD_DIM)
    vc = vc.reshape(b, lc, SWA_KV_HEADS, SWA_HEAD_DIM)
    y = window_attention(q, k, v, kc, vc, sink)
    y_c = context_gqa(qc.reshape(b, lc, SWA_HEADS, SWA_HEAD_DIM), kc, vc, sink) if need_ctx else None
    return y, y_c


def hgrn2_gates(z, lb):
    z = z.astype(F32)
    log_f = jnp.logaddexp(jnp.log(lb), jnp.log1p(-lb) + jax.nn.log_sigmoid(z))
    k = (1.0 - lb) * jax.nn.sigmoid(-z)
    shape = z.shape[:2] + (HG_HEADS, HG_DK)
    return log_f.reshape(shape), k.reshape(shape)


def hgrn2_chunked(q, log_f, k, v, s0):
    b, t, h, _ = q.shape
    dv = v.shape[-1]
    n = t // HG_CHUNK

    def chunks(a):
        return a.reshape(b, n, HG_CHUNK, h, a.shape[-1])

    q, log_f, k, v = chunks(q), chunks(log_f), chunks(k), chunks(v)
    cum = jnp.cumsum(log_f, axis=2)
    last = cum[:, :, -1]
    q_dec = q * jnp.exp(cum)
    k_inv = k * jnp.exp(-cum)
    k_end = k * jnp.exp(last[:, :, None] - cum)
    lower_tri = jnp.tril(jnp.ones((HG_CHUNK, HG_CHUNK), dtype=bool))
    att = jnp.where(lower_tri, jnp.einsum('bnthd,bnshd->bnhts', q_dec, k_inv), 0.0)
    o_intra = jnp.einsum('bnhts,bnshv->bnthv', att, v)
    kv = jnp.einsum('bnshd,bnshv->bnhdv', k_end, v)

    def step(state, inp):
        dec, kv_c = inp
        return dec[..., None] * state + kv_c, state

    s_final, s_prev = lax.scan(step, s0, (jnp.exp(last).swapaxes(0, 1), kv.swapaxes(0, 1)))
    o_inter = jnp.einsum('bnthd,bnhdv->bnthv', q_dec, s_prev.swapaxes(0, 1))
    return (o_intra + o_inter).reshape(b, t, h, dv), s_final


def hgrn2_final_state(log_f, k, v):
    cum = jnp.cumsum(log_f, axis=1)
    return jnp.einsum('bthd,bthv->bhdv', k * jnp.exp(cum[:, -1:] - cum), v)


def hgrn2_mixer(q, z_f, z_b, i_in, g, q_c, z_f_c, z_b_c, i_c, g_c, lb_f, lb_b, norm_g, need_ctx):
    def heads(a, d):
        return a.astype(F32).reshape(a.shape[0], a.shape[1], HG_HEADS, d)

    def flip(a):
        return jnp.flip(a, 1)

    def gate_out(o, gate):
        o = rms_norm(o, norm_g)
        return o.reshape(o.shape[0], o.shape[1], HG_HEADS * HG_DV) * jax.nn.silu(gate.astype(F32))

    lf_f, k_f = hgrn2_gates(z_f, lb_f)
    lf_b, k_b = hgrn2_gates(z_b, lb_b)
    lfc_f, kc_f = hgrn2_gates(z_f_c, lb_f)
    lfc_b, kc_b = hgrn2_gates(z_b_c, lb_b)
    qh, vh = heads(q, HG_DK), heads(i_in, HG_DV)
    vch = heads(i_c, HG_DV)
    if need_ctx:
        qch = heads(q_c, HG_DK)
        zero = jnp.zeros((q.shape[0], HG_HEADS, HG_DK, HG_DV), F32)
        oc_f, sc_f = hgrn2_chunked(qch, lfc_f, kc_f, vch, zero)
        oc_b, sc_b = hgrn2_chunked(flip(qch), flip(lfc_b), flip(kc_b), flip(vch), zero)
        y_c = gate_out(oc_f + flip(oc_b), g_c).astype(q_c.dtype)
    else:
        sc_f = hgrn2_final_state(lfc_f, kc_f, vch)
        sc_b = hgrn2_final_state(flip(lfc_b), flip(kc_b), flip(vch))
        y_c = None
    o_f, _ = hgrn2_chunked(qh, lf_f, k_f, vh, sc_f)
    o_b, _ = hgrn2_chunked(flip(qh), flip(lf_b), flip(k_b), flip(vh), sc_b)
    y = gate_out(o_f + flip(o_b), g).astype(q.dtype)
    return y, y_c


def mla_queries(cq, q_norm_g, w_qb, rope):
    b, t, _ = cq.shape
    q = (rms_norm(cq, q_norm_g) @ w_qb).reshape(b, t, MLA_HEADS, MLA_NOPE + MLA_ROPE)
    q_nope, q_rope = q[..., :MLA_NOPE], q[..., MLA_NOPE:]
    if rope is not None:
        q_rope = apply_axial_rope(q_rope, *rope)
    return q_nope, q_rope


def mla_keys(ckv, kr, kv_norm_g, w_kvb, rope):
    b, t, _ = ckv.shape
    kv = (rms_norm(ckv, kv_norm_g) @ w_kvb).reshape(b, t, MLA_HEADS, MLA_NOPE + MLA_V)
    k_rope = kr[:, :, None, :]
    if rope is not None:
        k_rope = apply_axial_rope(k_rope, *rope)
    return kv[..., :MLA_NOPE], k_rope[:, :, 0], kv[..., MLA_NOPE:]


def mla_attend(q_nope, q_rope, k_nope, k_rope, v):
    s = (jnp.einsum('bqhd,bkhd->bhqk', q_nope, k_nope)
         + jnp.einsum('bqhd,bkd->bhqk', q_rope, k_rope))
    p = jax.nn.softmax(s.astype(F32) * MLA_SCALE, axis=-1).astype(v.dtype)
    return jnp.einsum('bhqk,bkhd->bqhd', p, v)


def mla_mixer(cq, ckv, kr, cq_c, ckv_c, kr_c, q_norm_g, w_qb, kv_norm_g, w_kvb, rope, need_ctx):
    b, l, _ = cq.shape
    nb = l // BLOCK
    qn, qr = mla_queries(cq, q_norm_g, w_qb, rope)
    kn, krr, v = mla_keys(ckv, kr, kv_norm_g, w_kvb, rope)
    kn_c, krr_c, v_c = mla_keys(ckv_c, kr_c, kv_norm_g, w_kvb, None)
    kn_all = jnp.concatenate([kn_c, kn], axis=1)
    kr_all = jnp.concatenate([krr_c, krr], axis=1)
    v_all = jnp.concatenate([v_c, v], axis=1)

    def to_blocks(a):
        return a.reshape((b, nb, BLOCK) + a.shape[2:]).swapaxes(0, 1)

    o = lax.map(lambda qs: mla_attend(qs[0], qs[1], kn_all, kr_all, v_all),
                (to_blocks(qn), to_blocks(qr)))
    y = o.swapaxes(0, 1).reshape(b, l, MLA_HEADS * MLA_V)
    y_c = None
    if need_ctx:
        qn_c, qr_c = mla_queries(cq_c, q_norm_g, w_qb, None)
        y_c = mla_attend(qn_c, qr_c, kn_c, krr_c, v_c).reshape(b, -1, MLA_HEADS * MLA_V)
    return y, y_c


def hybrid_mixer(hx, hc, w_in, w_out,
                 s5_lam_re, s5_lam_im, s5_log_dt, s5_b_re, s5_b_im, s5_c_re, s5_c_im,
                 s5_d, s5_w_glu, s5_b_glu, swa_sink, lb_f, lb_b, hg_norm_g,
                 mla_q_norm_g, mla_w_qb, mla_kv_norm_g, mla_w_kvb,
                 rope_attn, rope_mla, need_ctx):
    px = split_cols(hx @ w_in)
    pc = split_cols(hc @ w_in)
    ya, ya_c = s5_mixer(px[0], pc[0], s5_lam_re, s5_lam_im, s5_log_dt, s5_b_re, s5_b_im,
                        s5_c_re, s5_c_im, s5_d, s5_w_glu, s5_b_glu, need_ctx)
    yb, yb_c = swa_mixer(px[1], px[2], px[3], pc[1], pc[2], pc[3], swa_sink, rope_attn, need_ctx)
    yc, yc_c = hgrn2_mixer(px[4], px[5], px[6], px[7], px[8], pc[4], pc[5], pc[6], pc[7], pc[8],
                           lb_f, lb_b, hg_norm_g, need_ctx)
    yd, yd_c = mla_mixer(px[9], px[10], px[11], pc[9], pc[10], pc[11],
                         mla_q_norm_g, mla_w_qb, mla_kv_norm_g, mla_w_kvb, rope_mla, need_ctx)
    dt = hx.dtype
    y = jnp.concatenate([ya.astype(dt), yb.astype(dt), yc.astype(dt), yd.astype(dt)], axis=-1) @ w_out
    y_c = None
    if need_ctx:
        y_c = jnp.concatenate([ya_c.astype(dt), yb_c.astype(dt), yc_c.astype(dt), yd_c.astype(dt)],
                              axis=-1) @ w_out
    return y, y_c


def setup_inputs(seed: int = 0) -> dict:
    key = jax.random.key(seed)
    ks = iter(jax.random.split(key, 32))

    def nrm(shape, scale):
        return jax.random.normal(next(ks), shape, F32) * scale

    L = DEPTH
    G, P = S5_GROUPS, S5_STATE
    n_idx = jnp.arange(P, dtype=F32)
    return {
        'x': nrm((BATCH, SEQ, D_MODEL), 1.0),
        'c': nrm((BATCH, D_MODEL), 1.0),
        'ctx': nrm((BATCH, CTX_LEN, D_MODEL), 1.0),
        'c_ctx': nrm((D_MODEL,), 1.0),
        'w_mod': nrm((L, D_MODEL, 6 * D_MODEL), 0.5 * D_MODEL ** -0.5),
        'b_mod': nrm((L, 6 * D_MODEL), 0.01),
        'norm1_g': 1.0 + nrm((L, D_MODEL), 0.02),
        'norm2_g': 1.0 + nrm((L, D_MODEL), 0.02),
        'w_in': nrm((L, D_MODEL, N_IN), D_MODEL ** -0.5),
        'w_out': nrm((L, D_MIX, D_MODEL), D_MIX ** -0.5),
        's5_lam_re': -0.5 + nrm((L, 2, G, P), 0.01),
        's5_lam_im': math.pi * n_idx + nrm((L, 2, G, P), 0.01),
        's5_log_dt': jax.random.uniform(next(ks), (L, 2, G, P), F32, math.log(1e-3), math.log(1e-1)),
        's5_b_re': nrm((L, 2, G, P, S5_GROUP), (2 * S5_GROUP) ** -0.5),
        's5_b_im': nrm((L, 2, G, P, S5_GROUP), (2 * S5_GROUP) ** -0.5),
        's5_c_re': nrm((L, 2, G, S5_GROUP, P), (2 * P) ** -0.5),
        's5_c_im': nrm((L, 2, G, S5_GROUP, P), (2 * P) ** -0.5),
        's5_d': nrm((L, S5_CH), 1.0),
        's5_w_glu': nrm((L, S5_CH, S5_CH), S5_CH ** -0.5),
        's5_b_glu': nrm((L, S5_CH), 0.01),
        'swa_sink': nrm((L, SWA_HEADS), 0.5),
        'hg_lb': nrm((2, L, HG_HEADS * HG_DK), 1.0),
        'hg_norm_g': 1.0 + nrm((L, HG_DV), 0.02),
        'mla_q_norm_g': 1.0 + nrm((L, MLA_Q_RANK), 0.02),
        'mla_w_qb': nrm((L, MLA_Q_RANK, MLA_HEADS * (MLA_NOPE + MLA_ROPE)), MLA_Q_RANK ** -0.5),
        'mla_kv_norm_g': 1.0 + nrm((L, MLA_KV_RANK), 0.02),
        'mla_w_kvb': nrm((L, MLA_KV_RANK, MLA_HEADS * (MLA_NOPE + MLA_V)), MLA_KV_RANK ** -0.5),
        'ffn_w_up': nrm((L, D_MODEL, 2 * FFN_HIDDEN), D_MODEL ** -0.5),
        'ffn_w_down': nrm((L, FFN_HIDDEN, D_MODEL), FFN_HIDDEN ** -0.5),
        'final_norm_g': 1.0 + nrm((D_MODEL,), 0.02),
    }


def reference(x, c, ctx, c_ctx, w_mod, b_mod, norm1_g, norm2_g, w_in, w_out,
              s5_lam_re, s5_lam_im, s5_log_dt, s5_b_re, s5_b_im, s5_c_re, s5_c_im,
              s5_d, s5_w_glu, s5_b_glu, swa_sink, hg_lb, hg_norm_g,
              mla_q_norm_g, mla_w_qb, mla_kv_norm_g, mla_w_kvb,
              ffn_w_up, ffn_w_down, final_norm_g):
    length = x.shape[1]
    rope_attn = axial_rope_tables(length, SWA_HEAD_DIM)
    rope_mla = axial_rope_tables(length, MLA_ROPE)
    lb_cum = jnp.cumsum(jax.nn.softmax(hg_lb.astype(F32), axis=1), axis=1)
    lb = lb_cum - lb_cum[:, :1]
    silu_c = jax.nn.silu(c)
    silu_cc = jax.nn.silu(c_ctx)
    for i in range(DEPTH):
        need_ctx = i < DEPTH - 1
        mod = (silu_c @ w_mod[i] + b_mod[i])[:, None, :]
        mod_c = silu_cc @ w_mod[i] + b_mod[i]
        sh1, sc1, g1, sh2, sc2, g2 = jnp.split(mod, 6, axis=-1)
        csh1, csc1, cg1, csh2, csc2, cg2 = jnp.split(mod_c, 6, axis=-1)
        hx = rms_norm(x, norm1_g[i]) * (1.0 + sc1) + sh1
        hc = rms_norm(ctx, norm1_g[i]) * (1.0 + csc1) + csh1
        y, y_c = hybrid_mixer(hx, hc, w_in[i], w_out[i],
                              s5_lam_re[i], s5_lam_im[i], s5_log_dt[i], s5_b_re[i], s5_b_im[i],
                              s5_c_re[i], s5_c_im[i], s5_d[i], s5_w_glu[i], s5_b_glu[i],
                              swa_sink[i], lb[0, i], lb[1, i], hg_norm_g[i],
                              mla_q_norm_g[i], mla_w_qb[i], mla_kv_norm_g[i], mla_w_kvb[i],
                              rope_attn, rope_mla, need_ctx)
        x = x + g1 * y
        hx = rms_norm(x, norm2_g[i]) * (1.0 + sc2) + sh2
        x = x + g2 * swiglu(hx, ffn_w_up[i], ffn_w_down[i])
        if need_ctx:
            ctx = ctx + cg1 * y_c
            hc = rms_norm(ctx, norm2_g[i]) * (1.0 + csc2) + csh2
            ctx = ctx + cg2 * swiglu(hc, ffn_w_up[i], ffn_w_down[i])
    return rms_norm(x, final_norm_g)
```

```cpp
#include <hip/hip_runtime.h>
#include <hip/hip_cooperative_groups.h>
#include <cstdio>
#include <type_traits>
namespace cg = cooperative_groups;

#define DI __device__ __forceinline__
typedef unsigned short bf16_t;
using bf16x8 = __attribute__((ext_vector_type(8))) short;
using f32x16 = __attribute__((ext_vector_type(16))) float;
using f32x4  = __attribute__((ext_vector_type(4))) float;

constexpr int DM = 1024, NBATCH = 4, SEQ = 8192, CTXL = 256, TT = SEQ + CTXL, R = NBATCH * TT, DEPTH = 4;
constexpr int NIN = 2464, FH = 2816;
constexpr int NINP = 2496;
constexpr int NCH = TT / 32;
constexpr int NCHR = NBATCH * NCH;
constexpr int NSC = TT / 128;
constexpr float LOG2E = 1.4426950408889634f;
constexpr float EPSN = 1e-6f;
constexpr int NTHR = 512;
constexpr int LDS_BYTES = 147456 + 1024;

#define MFMA32(a, b, c) __builtin_amdgcn_mfma_f32_32x32x16_bf16((a), (b), (c), 0, 0, 0)
#define MFMA16(a, b, c) __builtin_amdgcn_mfma_f32_16x16x32_bf16((a), (b), (c), 0, 0, 0)

DI int tid_() { int t = threadIdx.x; asm volatile("" : "+v"(t)); return t; }
DI int bid_() { int b = blockIdx.x; asm volatile("" : "+s"(b)); return b; }
typedef __bf16 hwbf2_t __attribute__((ext_vector_type(2)));
typedef float hwf2_t __attribute__((ext_vector_type(2)));
DI unsigned pack2(float a, float b) { hwf2_t f = {a, b}; return __builtin_bit_cast(unsigned, __builtin_convertvector(f, hwbf2_t)); }
DI bf16_t f2bf(float x) { return (bf16_t)(pack2(x, 0.f) & 0xffffu); }
DI float bf2f(bf16_t b) { return __uint_as_float(((unsigned)b) << 16); }
DI int crow(int reg, int h) { return (reg & 3) + 8 * (reg >> 2) + 4 * h; }
DI float sigmoidf_(float x) { return 1.f / (1.f + expf(-x)); }
DI float fsigmoid(float x) { return __builtin_amdgcn_rcpf(1.f + __expf(-x)); }
DI float wave_sum(float v) {
#pragma unroll
  for (int o = 32; o > 0; o >>= 1) v += __shfl_xor(v, o, 64);
  return v;
}


DI void my_sincos(float x, float* sn, float* cs) {
  const float q = rintf(x * 0.6366197723675814f);
  float r = fmaf(-q, 1.5707962512969971f, x);
  r = fmaf(-q, 7.549789415861596e-08f, r);
  r = fmaf(-q, 5.390302529957765e-15f, r);
  const float r2 = r * r;
  const float sp = r + r * r2 * (-1.6666667e-1f + r2 * (8.3333333e-3f + r2 * (-1.98412698e-4f + r2 * 2.7557319e-6f)));
  const float cp = 1.f + r2 * (-0.5f + r2 * (4.1666667e-2f + r2 * (-1.3888889e-3f + r2 * (2.48015873e-5f - r2 * 2.7557319e-7f))));
  const int qi = ((int)q) & 3;
  const float s_ = (qi & 1) ? cp : sp, c_ = (qi & 1) ? sp : cp;
  *sn = (qi < 2) ? s_ : -s_;
  *cs = (qi == 0 || qi == 3) ? c_ : -c_;
}

struct Params {
  const float *x, *c, *ctx, *c_ctx, *w_mod, *b_mod, *norm1_g, *norm2_g, *w_in, *w_out;
  const float *lam_re, *lam_im, *log_dt, *b_re, *b_im, *c_re, *c_im, *s5_d, *w_glu, *b_glu;
  const float *sink, *hg_lb, *hg_norm_g, *q_norm_g, *w_qb, *kv_norm_g, *w_kvb, *w_up, *w_down, *final_g;
  float* out;
  float *Xc, *mod, *lb, *ropeS, *ropeM, *apow, *bbar, *Ktab;
  bf16_t *Wi, *Wo, *Wu, *Wd, *Wg, *Wq, *Wkv, *TW, *W1;
  bf16_t *Hn;
  bf16_t *H;
  bf16_t *Pu, *PH, *Pm, *Qs, *Ks, *VsT, *Qm, *Km, *VmT, *Yg, *OF, *OB;
  float *Es5, *Eh, *dech;
  unsigned* bar;
};


DI void grid_barrier(unsigned* bar, unsigned ep) {
  asm volatile("s_waitcnt vmcnt(0)" ::: "memory");
  __syncthreads();
  if (threadIdx.x == 0) {
    const unsigned G = gridDim.x, g = blockIdx.x & 7u, nloc = (G - g + 7u) >> 3, ng = G < 8u ? G : 8u;
    __builtin_amdgcn_fence(__ATOMIC_RELEASE, "agent");
    asm volatile("s_waitcnt vmcnt(0)" ::: "memory");
    const unsigned old = __hip_atomic_fetch_add(&bar[64 * g], 1u, __ATOMIC_RELAXED, __HIP_MEMORY_SCOPE_AGENT);
    if (old + 1u == ep * nloc) {
      const unsigned og = __hip_atomic_fetch_add(&bar[1024], 1u, __ATOMIC_RELAXED, __HIP_MEMORY_SCOPE_AGENT);
      if (og + 1u == ep * ng) __hip_atomic_store(&bar[1088], ep, __ATOMIC_RELAXED, __HIP_MEMORY_SCOPE_AGENT);
      else while (__hip_atomic_load(&bar[1088], __ATOMIC_RELAXED, __HIP_MEMORY_SCOPE_AGENT) < ep) __builtin_amdgcn_s_sleep(1);
      __hip_atomic_store(&bar[512 + 64 * g], ep, __ATOMIC_RELAXED, __HIP_MEMORY_SCOPE_AGENT);
    } else {
      while (__hip_atomic_load(&bar[512 + 64 * g], __ATOMIC_RELAXED, __HIP_MEMORY_SCOPE_AGENT) < ep) __builtin_amdgcn_s_sleep(1);
    }
    __builtin_amdgcn_fence(__ATOMIC_ACQUIRE, "agent");
    asm volatile("s_waitcnt vmcnt(0)" ::: "memory");
  }
  __syncthreads();
}

DI const float* xsrc_row(const Params& p, bool first, int row) {
  int b = row / TT, t = row - b * TT;
  if (t < CTXL) return (first ? p.ctx : p.Xc) + ((size_t)b * CTXL + t) * DM;
  return (first ? p.x : p.out) + ((size_t)b * SEQ + (t - CTXL)) * DM;
}
DI float* xdst_row(const Params& p, int row) {
  int b = row / TT, t = row - b * TT;
  if (t < CTXL) return p.Xc + ((size_t)b * CTXL + t) * DM;
  return p.out + ((size_t)b * SEQ + (t - CTXL)) * DM;
}

DI int perm_col(int kind, int n) {
  if (kind == 0) {
    { const int c = n & 63; n = (n & ~63) + ((c >> 2) & 3) * 16 + ((c >> 4) & 3) * 4 + (c & 3); }
    if (n >= NIN) return -1;
    if (n >= 256 && n < 640) { int base = n & ~63, d = n & 63; int a = d >> 5, f = (d & 31) >> 1, hf = d & 1; return base + a * 32 + hf * 16 + f; }
    if (n >= 2432) { int e = n - 2432; int a = e >> 4, f = (e & 15) >> 1, hf = e & 1; return 2432 + a * 16 + hf * 8 + f; }
    return n;
  } else if (kind == 1) {
    int hd = n / 96, dd = n - hd * 96;
    if (dd >= 64) { int e = dd - 64; int a = e >> 4, f = (e & 15) >> 1, hf = e & 1; dd = 64 + a * 16 + hf * 8 + f; }
    return hd * 96 + dd;
  } else if (kind == 2) {
    const int grp = n >> 6, c = n & 63;
    const int nt = (c >> 4) & 3, q4 = (c >> 2) & 3, jj = c & 3;
    return (jj & 1) * FH + grp * 32 + q4 * 8 + nt * 2 + (jj >> 1);
  }
  return n;
}

template <int KT>
DI void conv_tile(float* tile, const float* __restrict__ src, int ldsrc, const float* __restrict__ rscale,
                  bf16_t* __restrict__ dst, int K, int n0, int k0, int kind) {
  const int j = tid_() & 31, i = tid_() >> 5;
  const int sc0 = perm_col(kind, n0 + j);
  const int sc = max(sc0, 0);
  const float scm = sc0 >= 0 ? 1.f : 0.f;
  constexpr int NL = KT / 16;
  float v[NL];
#pragma unroll
  for (int e = 0; e < NL; ++e) v[e] = src[(size_t)(k0 + i + 16 * e) * ldsrc + sc] * scm;
  if (rscale) {
#pragma unroll
    for (int e = 0; e < NL; ++e) v[e] *= rscale[k0 + i + 16 * e];
  }
#pragma unroll
  for (int e = 0; e < NL; ++e) tile[(i + 16 * e) * 33 + j] = v[e];
  __syncthreads();
  const int nn = tid_() >> 4, kq = (tid_() & 15) * 8;
#pragma unroll
  for (int ps = 0; ps < KT / 128; ++ps) {
    float o[8];
#pragma unroll
    for (int e = 0; e < 8; ++e) o[e] = tile[(ps * 128 + kq + e) * 33 + nn];
    *(uint4*)(dst + (size_t)(n0 + nn) * K + k0 + ps * 128 + kq) = make_uint4(pack2(o[0], o[1]), pack2(o[2], o[3]), pack2(o[4], o[5]), pack2(o[6], o[7]));
  }
  __syncthreads();
}

DI void mod_job(float* red, const Params& p, int jm) {
  const int l = jm / 192, cb = (jm % 192) * 32;
  const int j = tid_() & 31, ks = tid_() >> 5;
  const float* wm = p.w_mod + (size_t)l * DM * 6144 + cb + j;
  float a0 = 0, a1 = 0, a2 = 0, a3 = 0, a4 = 0;
  for (int k = ks * 64; k < ks * 64 + 64; ++k) {
    float w = wm[(size_t)k * 6144];
    float c0 = p.c[k], c1 = p.c[1024 + k], c2 = p.c[2048 + k], c3 = p.c[3072 + k], c4 = p.c_ctx[k];
    a0 += w * c0 * sigmoidf_(c0); a1 += w * c1 * sigmoidf_(c1); a2 += w * c2 * sigmoidf_(c2);
    a3 += w * c3 * sigmoidf_(c3); a4 += w * c4 * sigmoidf_(c4);
  }
  red[(ks * 32 + j) * 5 + 0] = a0; red[(ks * 32 + j) * 5 + 1] = a1; red[(ks * 32 + j) * 5 + 2] = a2;
  red[(ks * 32 + j) * 5 + 3] = a3; red[(ks * 32 + j) * 5 + 4] = a4;
  __syncthreads();
  if (tid_() < 160) {
    int b = tid_() >> 5, jj = tid_() & 31;
    float s = p.b_mod[l * 6144 + cb + jj];
    for (int q = 0; q < 16; ++q) s += red[(q * 32 + jj) * 5 + b];
    p.mod[(size_t)(l * 5 + b) * 6144 + cb + jj] = s;
  }
  __syncthreads();
}

DI void misc_job(const Params& p) {
  const int tid = tid_();
  if (tid < 256)
  for (int dirn = 0; dirn < 2; ++dirn) {
    float v[4], mx = -1e30f;
    for (int l = 0; l < 4; ++l) { v[l] = p.hg_lb[(dirn * 4 + l) * 256 + tid]; mx = fmaxf(mx, v[l]); }
    float s = 0; for (int l = 0; l < 4; ++l) { v[l] = expf(v[l] - mx); s += v[l]; }
    float cum = 0, first = 0;
    for (int l = 0; l < 4; ++l) { cum += v[l] / s; if (l == 0) first = cum; p.lb[(dirn * 4 + l) * 256 + tid] = cum - first; }
  }
  for (int e = tid; e < 128 * 16; e += NTHR) {
    int pos = e >> 4, f = e & 15;
    float inv = exp2f(-(float)f * (13.287712379549449f / 16.f));
    float ang = (float)pos * inv, sn, cs;
    my_sincos(ang, &sn, &cs);
    p.ropeS[2 * e] = cs; p.ropeS[2 * e + 1] = sn;
  }
  for (int e = tid; e < 128 * 8; e += NTHR) {
    int pos = e >> 3, f = e & 7;
    float inv = exp2f(-(float)f * (13.287712379549449f / 8.f));
    float ang = (float)pos * inv, sn, cs;
    my_sincos(ang, &sn, &cs);
    p.ropeM[2 * e] = cs; p.ropeM[2 * e + 1] = sn;
  }
}

DI void s5tab_job(float* sm, const Params& p, int jb) {
  float2* s_ap = (float2*)sm;
  float2* s_bb = s_ap + 33 * 64;
  float2* s_c = s_bb + 64 * 16;
  const int tid = tid_();
  if (tid < 64) {
    const int pi = jb * 64 + tid;
    float lr = p.lam_re[pi], li = p.lam_im[pi], dt = expf(p.log_dt[pi]);
    float zr = lr * dt, zi = li * dt;
#pragma unroll 1
    for (int t = 0; t <= 32; ++t) {
      float mag = expf((float)t * zr), ang = (float)t * zi, sn, cs;
      my_sincos(ang, &sn, &cs);
      float2 v = make_float2(mag * cs, mag * sn);
      s_ap[t * 64 + tid] = v;
      p.apow[((size_t)jb * 33 + t) * 128 + tid * 2] = v.x;
      p.apow[((size_t)jb * 33 + t) * 128 + tid * 2 + 1] = v.y;
    }
    float cr, ci;
    if (zr * zr + zi * zi < 0.01f) {
      float pr = 1.f, pi_ = 0.f, tr = 1.f, ti = 0.f;
#pragma unroll
      for (int n = 2; n <= 7; ++n) {
        const float nr = (tr * zr - ti * zi) / (float)n, ni = (tr * zi + ti * zr) / (float)n;
        tr = nr; ti = ni; pr += tr; pi_ += ti;
      }
      cr = dt * pr; ci = dt * pi_;
    } else {
      float sn1, cs1;
      my_sincos(zi, &sn1, &cs1);
      const float ar = expf(zr) * cs1 - 1.f, ai = expf(zr) * sn1;
      const float den = lr * lr + li * li;
      cr = (ar * lr + ai * li) / den; ci = (ai * lr - ar * li) / den;
    }
#pragma unroll 1
    for (int hh = 0; hh < 16; ++hh) {
      float br = p.b_re[(size_t)pi * 16 + hh], bi = p.b_im[(size_t)pi * 16 + hh];
      float2 v = make_float2(cr * br - ci * bi, cr * bi + ci * br);
      s_bb[tid * 16 + hh] = v;
      p.bbar[((size_t)pi * 16 + hh) * 2] = v.x; p.bbar[((size_t)pi * 16 + hh) * 2 + 1] = v.y;
    }
  }
  for (int e = tid; e < 1024; e += NTHR) s_c[e] = make_float2(p.c_re[(size_t)jb * 1024 + e], p.c_im[(size_t)jb * 1024 + e]);
  __syncthreads();
  const int hh = (tid >> 4) & 15, hp = tid & 15, th = tid >> 8;
#pragma unroll 1
  for (int t = th; t < 32; t += 2) {
    float acc = 0;
#pragma unroll 4
    for (int q = 0; q < 64; ++q) {
      float2 c = s_c[hh * 64 + q], a = s_ap[t * 64 + q], b = s_bb[q * 16 + hp];
      float wr = c.x * a.x - c.y * a.y, wi = c.x * a.y + c.y * a.x;
      acc += wr * b.x - wi * b.y;
    }
    p.Ktab[((size_t)jb * 32 + t) * 256 + (tid & 255)] = acc;
  }
  __syncthreads();
}

constexpr int J_MOD = 768;
constexpr int CT_WI = 78 * 4, CT_WO = 32 * 4, CT_WU = 176 * 4, CT_WD = 32 * 11, CT_WG = 8 * 1, CT_WQ = 12 * 1, CT_WKV = 16 * 1;
constexpr int CT_LAYER = CT_WI + CT_WO + CT_WU + CT_WD + CT_WG + CT_WQ + CT_WKV;
constexpr int J_CONV = CT_LAYER * DEPTH;
constexpr int J_S5TAB = DEPTH * 2 * 16;

DI void phase_prep(char* smem, const Params& p) {
  float* sm = (float*)smem;
  const int total = J_MOD + J_S5TAB + 1 + J_CONV;
  for (int job = bid_(); job < total; job += gridDim.x) {
    int j = job;
    if (j < J_MOD) { mod_job(sm, p, j); continue; }
    j -= J_MOD;
    if (j < J_S5TAB) { s5tab_job(sm, p, j); continue; }
    j -= J_S5TAB;
    if (j < 1) { misc_job(p); continue; }
    j -= 1;
    const int l = j / CT_LAYER; int q = j - l * CT_LAYER;
    if (q < CT_WI) { int nt = q / 4, kt = q % 4; conv_tile<256>(sm, p.w_in + (size_t)l * DM * NIN, NIN, nullptr, p.Wi + (size_t)l * NINP * DM, DM, nt * 32, kt * 256, 0); continue; }
    q -= CT_WI;
    if (q < CT_WO) { int nt = q / 4, kt = q % 4; conv_tile<256>(sm, p.w_out + (size_t)l * DM * DM, DM, nullptr, p.Wo + (size_t)l * DM * DM, DM, nt * 32, kt * 256, 3); continue; }
    q -= CT_WO;
    if (q < CT_WU) { int nt = q / 4, kt = q % 4; conv_tile<256>(sm, p.w_up + (size_t)l * DM * 2 * FH, 2 * FH, nullptr, p.Wu + (size_t)l * 2 * FH * DM, DM, nt * 32, kt * 256, 2); continue; }
    q -= CT_WU;
    if (q < CT_WD) { int nt = q / 11, kt = q % 11; conv_tile<256>(sm, p.w_down + (size_t)l * FH * DM, DM, nullptr, p.Wd + (size_t)l * DM * FH, FH, nt * 32, kt * 256, 3); continue; }
    q -= CT_WD;
    if (q < CT_WG) { int nt = q, kt = 0; conv_tile<256>(sm, p.w_glu + (size_t)l * 65536, 256, nullptr, p.Wg + (size_t)l * 65536, 256, nt * 32, kt * 256, 3); continue; }
    q -= CT_WG;
    if (q < CT_WQ) { int nt = q, kt = 0; conv_tile<256>(sm, p.w_qb + (size_t)l * 256 * 384, 384, p.q_norm_g + l * 256, p.Wq + (size_t)l * 384 * 256, 256, nt * 32, kt * 256, 1); continue; }
    q -= CT_WQ;
    { int nt = q, kt = 0; conv_tile<128>(sm, p.w_kvb + (size_t)l * 128 * 512, 512, p.kv_norm_g + l * 128, p.Wkv + (size_t)l * 512 * 128, 128, nt * 32, kt * 128, 3); }
  }
}

DI void phase_s5mats(const Params& p) {
  const int TW_ROWS = DEPTH * 16 * 512, W1_ROWS = DEPTH * 16 * 256;
  const size_t n_tw = (size_t)TW_ROWS * 96, n_w1 = (size_t)W1_ROWS * 64;
  for (size_t e = (size_t)bid_() * NTHR + tid_(); e < n_tw + n_w1; e += (size_t)gridDim.x * NTHR) {
    float v[8];
    bf16_t* dst;
    if (e < n_tw) {
      const int row = (int)(e / 96), kg = (int)(e % 96);
      const int lg = row >> 9, n = row & 511, t = n >> 4, hh = n & 15;
      const int l = lg >> 4, g = lg & 15;
      const int k = kg * 8;
      dst = p.TW + (size_t)row * 768 + k;
      if (k < 512) {
        const int s = k >> 4, h0 = k & 15;
        const float* Kf = p.Ktab + ((size_t)((l * 2 + 0) * 16 + g) * 32) * 256;
        const float* Kb = p.Ktab + ((size_t)((l * 2 + 1) * 16 + g) * 32) * 256;
#pragma unroll
        for (int j = 0; j < 8; ++j) {
          float a = 0;
          if (s <= t) a += Kf[(t - s) * 256 + hh * 16 + h0 + j];
          if (s >= t) a += Kb[(s - t) * 256 + hh * 16 + h0 + j];
          if (s == t && hh == h0 + j) a += p.s5_d[l * 256 + g * 16 + hh];
          v[j] = a;
        }
      } else {
        const int dirn = (k - 512) >> 7, p0 = ((k - 512) & 127) >> 1;
        const int jb = (l * 2 + dirn) * 16 + g;
        const int ex = dirn == 0 ? t + 1 : 32 - t;
#pragma unroll
        for (int j = 0; j < 8; ++j) {
          const int pp = p0 + (j >> 1);
          float cr = p.c_re[((size_t)jb * 16 + hh) * 64 + pp], ci = p.c_im[((size_t)jb * 16 + hh) * 64 + pp];
          float ar = p.apow[((size_t)jb * 33 + ex) * 128 + pp * 2], ai = p.apow[((size_t)jb * 33 + ex) * 128 + pp * 2 + 1];
          v[j] = (j & 1) ? -(cr * ai + ci * ar) : (cr * ar - ci * ai);
        }
      }
    } else {
      const size_t e2 = e - n_tw;
      const int row = (int)(e2 / 64), kg = (int)(e2 % 64);
      const int lg = row >> 8, n = row & 255;
      const int l = lg >> 4, g = lg & 15;
      const int dirn = n >> 7, pp = (n & 127) >> 1, ri = n & 1;
      const int k = kg * 8, s = k >> 4, h0 = k & 15;
      const int jb = (l * 2 + dirn) * 16 + g;
      const int ex = dirn == 0 ? 31 - s : s;
      dst = p.W1 + (size_t)row * 512 + k;
      float ar = p.apow[((size_t)jb * 33 + ex) * 128 + pp * 2], ai = p.apow[((size_t)jb * 33 + ex) * 128 + pp * 2 + 1];
#pragma unroll
      for (int j = 0; j < 8; ++j) {
        float br = p.bbar[(((size_t)jb * 64 + pp) * 16 + h0 + j) * 2], bi = p.bbar[(((size_t)jb * 64 + pp) * 16 + h0 + j) * 2 + 1];
        v[j] = ri ? (ar * bi + ai * br) : (ar * br - ai * bi);
      }
    }
    uint4 o; o.x = pack2(v[0], v[1]); o.y = pack2(v[2], v[3]); o.z = pack2(v[4], v[5]); o.w = pack2(v[6], v[7]);
    *(uint4*)dst = o;
  }
}

DI void phase_norm(const Params& p, int layer, int which, bool first) {
  const int w = tid_() >> 6, l = tid_() & 63;
  const float* g = (which ? p.norm2_g : p.norm1_g) + layer * DM;
  for (int row = bid_() * 8 + w; row < R / 2; row += gridDim.x * 8) {
    float4 v[2][4]; float ss[2];
#pragma unroll
    for (int u = 0; u < 2; ++u) {
      const float* xr = xsrc_row(p, first, row + u * (R / 2));
      ss[u] = 0;
#pragma unroll
      for (int i = 0; i < 4; ++i) { v[u][i] = *(const float4*)(xr + i * 256 + l * 4); ss[u] += v[u][i].x * v[u][i].x + v[u][i].y * v[u][i].y + v[u][i].z * v[u][i].z + v[u][i].w * v[u][i].w; }
    }
#pragma unroll
    for (int u = 0; u < 2; ++u) {
      const int rw = row + u * (R / 2);
      const int b = rw / TT, t = rw - b * TT;
      const float* md = p.mod + (size_t)(layer * 5 + (t < CTXL ? 4 : b)) * 6144 + which * 3072;
      const float rs = rsqrtf(wave_sum(ss[u]) * (1.f / DM) + EPSN);
#pragma unroll
      for (int i = 0; i < 4; ++i) {
        const int c = i * 256 + l * 4;
        float4 gg = *(const float4*)(g + c), sh = *(const float4*)(md + c), sc = *(const float4*)(md + 1024 + c);
        float o0 = v[u][i].x * rs * gg.x * (1.f + sc.x) + sh.x, o1 = v[u][i].y * rs * gg.y * (1.f + sc.y) + sh.y;
        float o2 = v[u][i].z * rs * gg.z * (1.f + sc.z) + sh.z, o3 = v[u][i].w * rs * gg.w * (1.f + sc.w) + sh.w;
        uint2 o; o.x = pack2(o0, o1); o.y = pack2(o2, o3);
        *(uint2*)(p.Hn + (size_t)rw * DM + c) = o;
      }
    }
  }
}

DI void phase_final_norm(const Params& p) {
  const int w = tid_() >> 6, l = tid_() & 63;
  constexpr int NR = NBATCH * SEQ;
  for (int row = bid_() * 8 + w; row < NR / 2; row += gridDim.x * 8) {
    float4 v[2][4]; float ss[2];
#pragma unroll
    for (int u = 0; u < 2; ++u) {
      const float* xr = p.out + (size_t)(row + u * (NR / 2)) * DM;
      ss[u] = 0;
#pragma unroll
      for (int i = 0; i < 4; ++i) { v[u][i] = *(const float4*)(xr + i * 256 + l * 4); ss[u] += v[u][i].x * v[u][i].x + v[u][i].y * v[u][i].y + v[u][i].z * v[u][i].z + v[u][i].w * v[u][i].w; }
    }
#pragma unroll
    for (int u = 0; u < 2; ++u) {
      float* xr = p.out + (size_t)(row + u * (NR / 2)) * DM;
      const float rs = rsqrtf(wave_sum(ss[u]) * (1.f / DM) + EPSN);
#pragma unroll
      for (int i = 0; i < 4; ++i) {
        const int c = i * 256 + l * 4;
        float4 gg = *(const float4*)(p.final_g + c);
        *(float4*)(xr + c) = make_float4(v[u][i].x * rs * gg.x, v[u][i].y * rs * gg.y, v[u][i].z * rs * gg.z, v[u][i].w * rs * gg.w);
      }
    }
  }
}

template <int MI = 4, class AL, class EP>
DI void gemm_tile(char* smem, const AL& al, const bf16_t* __restrict__ B, int ldb, int N, const EP& ep, int m0, int n0, int K) {
  bf16_t* sA = (bf16_t*)smem;
  bf16_t* sB = sA + 2 * 256 * 72;
  const int tid = tid_(), w = tid >> 6, l = tid & 63, r = l & 31, h = l >> 5;
  const int wm = w >> 2, wn = w & 3;
  const int lrow = tid >> 3, lk = (tid & 7) * 8;
  f32x16 acc[MI][2];
#pragma unroll
  for (int a = 0; a < MI; ++a)
#pragma unroll
    for (int b = 0; b < 2; ++b)
#pragma unroll
      for (int i = 0; i < 16; ++i) acc[a][b][i] = 0.f;
  const bf16_t* Bp0 = B + (size_t)min(n0 + lrow, N - 1) * ldb + lk;
  const bf16_t* Bp1 = B + (size_t)min(n0 + lrow + 64, N - 1) * ldb + lk;
  const bf16_t* Bp2 = B + (size_t)min(n0 + lrow + 128, N - 1) * ldb + lk;
  const bf16_t* Bp3 = B + (size_t)min(n0 + lrow + 192, N - 1) * ldb + lk;
  uint4 xa0, xa1, xa2, xa3, xb0, xb1, xb2, xb3;
  xa1 = xa2 = xa3 = make_uint4(0, 0, 0, 0);
#define GLOADX(kk) \
  xa0 = al(m0 + lrow, (kk) + lk); if (MI > 1) xa1 = al(m0 + lrow + 64, (kk) + lk); if (MI > 2) { xa2 = al(m0 + lrow + 128, (kk) + lk); xa3 = al(m0 + lrow + 192, (kk) + lk); } \
  xb0 = *(const uint4*)(Bp0 + (kk)); xb1 = *(const uint4*)(Bp1 + (kk)); xb2 = *(const uint4*)(Bp2 + (kk)); xb3 = *(const uint4*)(Bp3 + (kk));
#define SSTOREX(bb) \
  *(uint4*)(sA + (bb) * 18432 + (lrow) * 72 + lk) = xa0; if (MI > 1) *(uint4*)(sA + (bb) * 18432 + (lrow + 64) * 72 + lk) = xa1; \
  if (MI > 2) { *(uint4*)(sA + (bb) * 18432 + (lrow + 128) * 72 + lk) = xa2; *(uint4*)(sA + (bb) * 18432 + (lrow + 192) * 72 + lk) = xa3; } \
  *(uint4*)(sB + (bb) * 18432 + (lrow) * 72 + lk) = xb0; *(uint4*)(sB + (bb) * 18432 + (lrow + 64) * 72 + lk) = xb1; \
  *(uint4*)(sB + (bb) * 18432 + (lrow + 128) * 72 + lk) = xb2; *(uint4*)(sB + (bb) * 18432 + (lrow + 192) * 72 + lk) = xb3;
  const int nk = K >> 6;
  GLOADX(0)
  __syncthreads();
  SSTOREX(0)
  GLOADX(min(1, nk - 1) * 64)
  for (int kt = 0; kt < nk; ++kt) {
    const int buf = kt & 1;
    __syncthreads();
    SSTOREX(buf ^ 1)
    __builtin_amdgcn_sched_barrier(0);
    GLOADX(min(kt + 2, nk - 1) * 64)
    __builtin_amdgcn_sched_barrier(0);
    const bf16_t* cA = sA + buf * 18432 + (wm * 32 * MI + r) * 72 + 8 * h;
    const bf16_t* cB = sB + buf * 18432 + (wn * 64 + r) * 72 + 8 * h;
#pragma unroll
    for (int ks = 0; ks < 4; ++ks) {
      bf16x8 b0 = *(const bf16x8*)(cB + ks * 16), b1 = *(const bf16x8*)(cB + 32 * 72 + ks * 16);
#pragma unroll
      for (int a = 0; a < MI; ++a) {
        bf16x8 af = *(const bf16x8*)(cA + a * 32 * 72 + ks * 16);
        acc[a][0] = MFMA32(b0, af, acc[a][0]);
        acc[a][1] = MFMA32(b1, af, acc[a][1]);
      }
    }
  }
#undef GLOADX
#undef SSTOREX
  const int row0 = m0 + wm * 32 * MI + r, cb0 = n0 + wn * 64 + 4 * h;
  if constexpr (std::is_invocable_v<EP, int, int, int, const f32x16&, const f32x16&>) {
#pragma unroll
    for (int a = 0; a < MI; ++a) ep(row0 + 32 * a, n0 + wn * 64, h, acc[a][0], acc[a][1]);
  } else {
#pragma unroll
    for (int a = 0; a < MI; ++a)
#pragma unroll
      for (int g = 0; g < 4; ++g) {
        ep(row0 + 32 * a, cb0 + 8 * g, acc[a][0][4 * g], acc[a][0][4 * g + 1], acc[a][0][4 * g + 2], acc[a][0][4 * g + 3]);
        ep(row0 + 32 * a, cb0 + 32 + 8 * g, acc[a][1][4 * g], acc[a][1][4 * g + 1], acc[a][1][4 * g + 2], acc[a][1][4 * g + 3]);
      }
  }
}


template <int MI = 4, class EP>
DI void gemm_tile_dma(char* smem, const bf16_t* __restrict__ A, int lda, const bf16_t* __restrict__ B, int ldb, int N,
                      const EP& ep, int m0, int n0, int K) {
  constexpr int STAGE = 65536;
  constexpr int MT = 2 * MI;
  const int tid = tid_(), w = tid >> 6, l = tid & 63, r16 = l & 15, q4 = l >> 4;
  const int wm = w >> 2, wn = w & 3;
  f32x4 acc[MT][4];
#pragma unroll
  for (int a = 0; a < MT; ++a)
#pragma unroll
    for (int b = 0; b < 4; ++b) { acc[a][b][0] = 0.f; acc[a][b][1] = 0.f; acc[a][b][2] = 0.f; acc[a][b][3] = 0.f; }
  const int srow = tid >> 3, slog = (tid & 7) ^ ((tid >> 4) & 7);
  const bf16_t* Ag = A + (size_t)(m0 + srow) * lda + slog * 8;
  const bf16_t* Bg0 = B + (size_t)min(n0 + srow, N - 1) * ldb + slog * 8;
  const bf16_t* Bg1 = B + (size_t)min(n0 + srow + 64, N - 1) * ldb + slog * 8;
  const bf16_t* Bg2 = B + (size_t)min(n0 + srow + 128, N - 1) * ldb + slog * 8;
  const bf16_t* Bg3 = B + (size_t)min(n0 + srow + 192, N - 1) * ldb + slog * 8;
  char* wbase = smem + w * 1024;
#define DMA16(g, lds) __builtin_amdgcn_global_load_lds((const unsigned*)(g), (unsigned*)(lds), 16, 0, 0)
#define STAGE_TILE(bb, kk) { char* sb_ = wbase + (bb) * STAGE; \
    DMA16(Ag + (kk), sb_); \
    if (MI > 1) DMA16(Ag + (size_t)64 * lda + (kk), sb_ + 8192); \
    if (MI > 2) { DMA16(Ag + (size_t)128 * lda + (kk), sb_ + 16384); DMA16(Ag + (size_t)192 * lda + (kk), sb_ + 24576); } \
    DMA16(Bg0 + (kk), sb_ + 32768); DMA16(Bg1 + (kk), sb_ + 32768 + 8192); \
    DMA16(Bg2 + (kk), sb_ + 32768 + 16384); DMA16(Bg3 + (kk), sb_ + 32768 + 24576); }
  const int nk = K >> 6;
  __syncthreads();
  STAGE_TILE(0, 0)
  asm volatile("s_waitcnt vmcnt(0)" ::: "memory");
  __syncthreads();
  const int swz = r16 >> 1;
  for (int kt = 0; kt < nk; ++kt) {
    const int buf = kt & 1;
    if (kt + 1 < nk) STAGE_TILE(buf ^ 1, (kt + 1) * 64)
    const char* cA = smem + buf * STAGE + (wm * 32 * MI + r16) * 128;
    const char* cB = smem + buf * STAGE + 32768 + (wn * 64 + r16) * 128;
#pragma unroll
    for (int k2 = 0; k2 < 2; ++k2) {
      const int po = ((4 * k2 + q4) ^ swz) * 16;
      bf16x8 bf[4];
#pragma unroll
      for (int nt = 0; nt < 4; ++nt) bf[nt] = *(const bf16x8*)(cB + nt * 16 * 128 + po);
      bf16x8 afc = *(const bf16x8*)(cA + po);
#pragma unroll
      for (int a = 0; a < MT; ++a) {
        bf16x8 afn = afc;
        if (a + 1 < MT) afn = *(const bf16x8*)(cA + (a + 1) * 16 * 128 + po);
        __builtin_amdgcn_sched_barrier(0);
#pragma unroll
        for (int nt = 0; nt < 4; ++nt) acc[a][nt] = MFMA16(bf[nt], afc, acc[a][nt]);
        __builtin_amdgcn_sched_barrier(0);
        afc = afn;
      }
    }
    asm volatile("s_waitcnt vmcnt(0)" ::: "memory");
    __syncthreads();
  }
#undef DMA16
#undef STAGE_TILE
  const int row0 = m0 + wm * 32 * MI + r16, cbw = n0 + wn * 64;
  if constexpr (std::is_invocable_v<EP, int, int, int, const f32x4&, const f32x4&, const f32x4&, const f32x4&>) {
#pragma unroll
    for (int a = 0; a < MT; ++a) ep(row0 + 16 * a, cbw, q4, acc[a][0], acc[a][1], acc[a][2], acc[a][3]);
  } else {
#pragma unroll
    for (int a = 0; a < MT; ++a)
#pragma unroll
      for (int nt = 0; nt < 4; ++nt)
        ep(row0 + 16 * a, cbw + 16 * nt + 4 * q4, acc[a][nt][0], acc[a][nt][1], acc[a][nt][2], acc[a][nt][3]);
  }
}

DI void row_rms(float* rs, const bf16_t* __restrict__ A, int lda, int m0, int K) {
  const int row = tid_() >> 1, hf = tid_() & 1;
  const bf16_t* a = A + (size_t)(m0 + row) * lda + hf * (K >> 1);
  float ss = 0;
  for (int k = 0; k < (K >> 1); k += 8) {
    uint4 v = *(const uint4*)(a + k);
    float lo, hi;
    lo = __uint_as_float(v.x << 16); hi = __uint_as_float(v.x & 0xffff0000u); ss += lo * lo + hi * hi;
    lo = __uint_as_float(v.y << 16); hi = __uint_as_float(v.y & 0xffff0000u); ss += lo * lo + hi * hi;
    lo = __uint_as_float(v.z << 16); hi = __uint_as_float(v.z & 0xffff0000u); ss += lo * lo + hi * hi;
    lo = __uint_as_float(v.w << 16); hi = __uint_as_float(v.w & 0xffff0000u); ss += lo * lo + hi * hi;
  }
  ss += __shfl_xor(ss, 1, 64);
  __syncthreads();
  if (hf == 0) rs[row] = rsqrtf(ss / (float)K + EPSN);
  __syncthreads();
}

template <int TMI, class F>
DI void for_tiles_xcd(int MT, int NT, const F& f) {
  const int total = MT * NT, G = gridDim.x, nslots = G >> 3;
  const int b = bid_(), x = b & 7, slot = b >> 3;
  const int total_full = (total / G) * G;
  const int full = (MT >> 3) * 8 * NT, gsz = MT - (MT >> 3) * 8;
  auto decode = [&](int L, int& mt, int& nt) {
    if (L < full) { const int mg = L / (8 * NT), rem = L - mg * 8 * NT; mt = mg * 8 + (rem & 7); nt = rem >> 3; }
    else { const int rem = L - full; nt = rem / gsz; mt = (MT >> 3) * 8 + (rem - nt * gsz); }
  };
  if (slot < nslots)
    for (int c = x; c * 32 < total_full; c += 8)
      for (int kk = slot; kk < 32; kk += nslots) {
        const int L = c * 32 + kk;
        if (L >= total_full) break;
        int mt, nt; decode(L, mt, nt);
        f(mt * 256, nt, std::integral_constant<int, 4>{});
      }
  constexpr int PIECES = 4 / TMI;
  const int npieces = (total - total_full) * PIECES;
  for (int q = b; q < npieces; q += G) {
    int mt, nt; decode(total_full + q / PIECES, mt, nt);
    f(mt * 256 + (q % PIECES) * 64 * TMI, nt, std::integral_constant<int, TMI>{});
  }
}

DI void phase_win(char* smem, const Params& p, int layer) {
  const bf16_t* Hn = p.Hn;
  auto al = [=](int row, int k) -> uint4 { return *(const uint4*)(Hn + (size_t)row * DM + k); };
  const float qscale = 0.125f * LOG2E;
  auto ep = [&](int row, int cbw, int q4, const f32x4& c0, const f32x4& c1, const f32x4& c2, const f32x4& c3) {
    if (cbw > 2432) return;
    const int b = row / TT, t = row - b * TT;
    const bool lat = t >= CTXL;
    const int pos = t - CTXL;
    float v[16] = {c0[0], c0[1], c0[2], c0[3], c1[0], c1[1], c1[2], c1[3], c2[0], c2[1], c2[2], c2[3], c3[0], c3[1], c3[2], c3[3]};
    if (cbw >= 640 && cbw < 768) {
      bf16_t* vp = p.VsT + ((size_t)(b * 2 + ((cbw - 640) >> 6)) * 64 + q4 * 16) * TT + t;
#pragma unroll
      for (int i = 0; i < 16; ++i) vp[(size_t)i * TT] = f2bf(v[i]);
      return;
    }
    const bool r16 = cbw >= 256 && cbw < 640, rkr = cbw == 2432;
    if (rkr && q4 >= 2) return;
    if (lat && (r16 || rkr)) {
      const int a = r16 ? (q4 >> 1) : q4;
      const int pa = a ? (pos & 63) : (pos >> 6);
      const float* tab = r16 ? p.ropeS + 2 * (pa * 16 + (q4 & 1) * 8) : p.ropeM + 2 * (pa * 8);
#pragma unroll
      for (int k = 0; k < 4; ++k) {
        const float4 cs = *(const float4*)(tab + 4 * k);
        const float x0 = v[4 * k], x1 = v[4 * k + 1], x2 = v[4 * k + 2], x3 = v[4 * k + 3];
        v[4 * k] = x0 * cs.x - x1 * cs.y; v[4 * k + 1] = x1 * cs.x + x0 * cs.y;
        v[4 * k + 2] = x2 * cs.z - x3 * cs.w; v[4 * k + 3] = x3 * cs.z + x2 * cs.w;
      }
    }
    if (cbw >= 256 && cbw < 512) {
#pragma unroll
      for (int i = 0; i < 16; ++i) v[i] *= qscale;
    }
    const uint4 lo = make_uint4(pack2(v[0], v[1]), pack2(v[2], v[3]), pack2(v[4], v[5]), pack2(v[6], v[7]));
    const uint4 hi = make_uint4(pack2(v[8], v[9]), pack2(v[10], v[11]), pack2(v[12], v[13]), pack2(v[14], v[15]));
    if (rkr) {
#pragma unroll
      for (int hd = 0; hd < 4; ++hd) {
        bf16_t* d = p.Km + ((size_t)(b * 4 + hd) * TT + t) * 96 + 64 + q4 * 16;
        *(uint4*)d = lo; *(uint4*)(d + 8) = hi;
      }
      return;
    }
    bf16_t* d;
    if (cbw < 256) d = p.Pu + (size_t)row * 256 + cbw;
    else if (cbw < 512) d = p.Qs + ((size_t)(b * 4 + ((cbw - 256) >> 6)) * TT + t) * 64;
    else if (cbw < 640) d = p.Ks + ((size_t)(b * 2 + ((cbw - 512) >> 6)) * TT + t) * 64;
    else if (cbw < 2048) d = p.PH + (size_t)row * 1280 + (cbw - 768);
    else d = p.Pm + (size_t)row * 384 + (cbw - 2048);
    d += q4 * 16;
    *(uint4*)d = lo; *(uint4*)(d + 8) = hi;
  };
  const bf16_t* W = p.Wi + (size_t)layer * NINP * DM;
  for_tiles_xcd<1>(R / 256, 10, [&](int m0, int nt, auto mi) { gemm_tile_dma<decltype(mi)::value>(smem, Hn, DM, W, DM, NINP, ep, m0, nt * 256, DM); });
}

DI int hg_tok(int dirn, int j) { return dirn == 0 ? j : (j < CTXL ? CTXL - 1 - j : TT + CTXL - 1 - j); }

template <bool FULL>
DI void hg_item(char* smem, const Params& p, int layer, int item) {
  bf16_t* qd = (bf16_t*)(smem + (tid_() >> 8) * 36864);
  bf16_t* ki = qd + 32 * 72;
  bf16_t* keT = ki + 32 * 72;
  bf16_t* vT = keT + 64 * 40;
  bf16_t* att = vT + 64 * 40;
  bf16_t* ST = att + 32 * 40;
  float* tot = (float*)(ST + 64 * 72);
  float* decs = tot + 256;
  const int tid = tid_() & 255, half = tid_() >> 8, w = tid >> 6, l = tid & 63, r16 = l & 15, q4 = l >> 4;
  item = item * 2 + half;
  const int sc = item % NSC, chain = item / NSC;
  const int dirn = chain & 1, head = (chain >> 1) & 3, b = chain >> 3;
  const int d = l, tq = w;
  __syncthreads();
  const float lbv = p.lb[(dirn * 4 + layer) * 256 + head * 64 + d];
  bf16_t* Odir = dirn ? p.OB : p.OF;
  float* Est = p.Eh + (size_t)item * 4096;
  f32x4 sacc[4];
#pragma unroll
  for (int di = 0; di < 4; ++di)
#pragma unroll
    for (int jj = 0; jj < 4; ++jj) {
      if (FULL) {
        const int v = w * 16 + q4 * 4 + jj, dd = di * 16 + r16;
        const float s0 = Est[v * 64 + dd];
        sacc[di][jj] = s0;
        ST[v * 72 + dd] = f2bf(s0);
      } else sacc[di][jj] = 0.f;
    }
  float dprod = 1.f;
  __syncthreads();
  bf16_t pz[4][8], pq[4][8], pv[4][8];
#pragma unroll
  for (int sub = 0; sub < 4; ++sub)
#pragma unroll
    for (int ii = 0; ii < 8; ++ii) {
      const int t = hg_tok(dirn, sc * 128 + sub * 32 + tq * 8 + ii);
      const bf16_t* ph = p.PH + ((size_t)b * TT + t) * 1280 + head * 64 + d;
      pz[sub][ii] = ph[dirn ? 512 : 256];
      if (FULL) pq[sub][ii] = ph[0];
      pv[sub][ii] = ph[768];
    }
#pragma unroll
  for (int sub = 0; sub < 4; ++sub) {
    const int j0 = sc * 128 + sub * 32;
    float cum[8], kk[8], qv[8], vv[8];
    float csum = 0;
#pragma unroll
    for (int ii = 0; ii < 8; ++ii) {
      const float z = bf2f(pz[sub][ii]);
      qv[ii] = FULL ? bf2f(pq[sub][ii]) : 0.f; vv[ii] = bf2f(pv[sub][ii]);
      const float sg = __builtin_amdgcn_rcpf(1.f + __expf(-z)), sgn = __builtin_amdgcn_rcpf(1.f + __expf(z));
      const float f = lbv + (1.f - lbv) * sg;
      kk[ii] = (1.f - lbv) * sgn;
      csum += __logf(f);
      cum[ii] = csum;
    }
    tot[tq * 64 + d] = csum;
    __syncthreads();
    float off = 0, last = 0;
#pragma unroll
    for (int q = 0; q < 4; ++q) { const float tv = tot[q * 64 + d]; last += tv; if (q < tq) off += tv; }
#pragma unroll
    for (int ii = 0; ii < 8; ++ii) {
      const int i = tq * 8 + ii;
      const float cu = off + cum[ii];
      if (FULL) { qd[i * 72 + d] = f2bf(qv[ii] * __expf(cu)); ki[i * 72 + d] = f2bf(kk[ii] * __expf(-cu)); }
      keT[d * 40 + i] = f2bf(kk[ii] * __expf(last - cu));
      vT[d * 40 + i] = f2bf(vv[ii]);
    }
    const float dl = __expf(last);
    if (tq == 0) { decs[d] = dl; dprod *= dl; }
    __syncthreads();
    if (FULL) {
      const int ti = w >> 1, si = w & 1;
      f32x4 acc = {0.f, 0.f, 0.f, 0.f};
#pragma unroll
      for (int ks = 0; ks < 2; ++ks) {
        bf16x8 a = *(const bf16x8*)(qd + (ti * 16 + r16) * 72 + ks * 32 + q4 * 8);
        bf16x8 bb = *(const bf16x8*)(ki + (si * 16 + r16) * 72 + ks * 32 + q4 * 8);
        acc = MFMA16(a, bb, acc);
      }
#pragma unroll
      for (int jj = 0; jj < 4; ++jj) {
        const int t = ti * 16 + q4 * 4 + jj, s = si * 16 + r16;
        att[t * 40 + s] = f2bf(s <= t ? acc[jj] : 0.f);
      }
      __syncthreads();
#pragma unroll
      for (int ti2 = 0; ti2 < 2; ++ti2) {
        f32x4 oacc = {0.f, 0.f, 0.f, 0.f};
        {
          bf16x8 a = *(const bf16x8*)(att + (ti2 * 16 + r16) * 40 + q4 * 8);
          bf16x8 bb = *(const bf16x8*)(vT + (w * 16 + r16) * 40 + q4 * 8);
          oacc = MFMA16(a, bb, oacc);
        }
#pragma unroll
        for (int ks = 0; ks < 2; ++ks) {
          bf16x8 a = *(const bf16x8*)(qd + (ti2 * 16 + r16) * 72 + ks * 32 + q4 * 8);
          bf16x8 bb = *(const bf16x8*)(ST + (w * 16 + r16) * 72 + ks * 32 + q4 * 8);
          oacc = MFMA16(a, bb, oacc);
        }
#pragma unroll
        for (int jj = 0; jj < 4; ++jj) {
          const int i = ti2 * 16 + q4 * 4 + jj;
          const int t = hg_tok(dirn, j0 + i);
          Odir[((size_t)b * TT + t) * 256 + head * 64 + w * 16 + r16] = f2bf(oacc[jj]);
        }
      }
    }
#pragma unroll
    for (int di = 0; di < 4; ++di) {
      bf16x8 a = *(const bf16x8*)(vT + (w * 16 + r16) * 40 + q4 * 8);
      bf16x8 bb = *(const bf16x8*)(keT + (di * 16 + r16) * 40 + q4 * 8);
      const float dc = decs[di * 16 + r16];
      f32x4 sv = sacc[di];
      sv[0] *= dc; sv[1] *= dc; sv[2] *= dc; sv[3] *= dc;
      sacc[di] = MFMA16(a, bb, sv);
    }
    if (FULL) {
      __syncthreads();
#pragma unroll
      for (int di = 0; di < 4; ++di)
#pragma unroll
        for (int jj = 0; jj < 4; ++jj) ST[(w * 16 + q4 * 4 + jj) * 72 + di * 16 + r16] = f2bf(sacc[di][jj]);
    }
  }
  if (!FULL) {
#pragma unroll
    for (int di = 0; di < 4; ++di)
#pragma unroll
      for (int jj = 0; jj < 4; ++jj) Est[(w * 16 + q4 * 4 + jj) * 64 + di * 16 + r16] = sacc[di][jj];
    if (tq == 0) p.dech[(size_t)item * 64 + d] = dprod;
  }
  __syncthreads();
}

DI void hg_state_item(char* smem, const Params& p, int layer, int item) {
  bf16_t* keT = (bf16_t*)(smem + (tid_() >> 8) * 36864);
  bf16_t* vT = keT + 64 * 136;
  float* tot = (float*)(vT + 64 * 136);
  const int tid = tid_() & 255, half = tid_() >> 8, w = tid >> 6, l = tid & 63, r16 = l & 15, q4 = l >> 4;
  item = item * 2 + half;
  const int sc = item % NSC, chain = item / NSC;
  const int dirn = chain & 1, head = (chain >> 1) & 3, b = chain >> 3;
  const int d = l, tq = w;
  __syncthreads();
  const float lbv = p.lb[(dirn * 4 + layer) * 256 + head * 64 + d];
  bf16_t pz[32], pv[32];
#pragma unroll
  for (int ii = 0; ii < 32; ++ii) {
    const int t = hg_tok(dirn, sc * 128 + tq * 32 + ii);
    const bf16_t* ph = p.PH + ((size_t)b * TT + t) * 1280 + head * 64 + d;
    pz[ii] = ph[dirn ? 512 : 256];
    pv[ii] = ph[768];
  }
  float cum[32], kk[32];
  float csum = 0;
#pragma unroll
  for (int ii = 0; ii < 32; ++ii) {
    const float z = bf2f(pz[ii]);
    const float sg = __builtin_amdgcn_rcpf(1.f + __expf(-z)), sgn = __builtin_amdgcn_rcpf(1.f + __expf(z));
    const float f = lbv + (1.f - lbv) * sg;
    kk[ii] = (1.f - lbv) * sgn;
    csum += __logf(f);
    cum[ii] = csum;
  }
  tot[tq * 64 + d] = csum;
  __syncthreads();
  float off = 0, last = 0;
#pragma unroll
  for (int q = 0; q < 4; ++q) { const float tv = tot[q * 64 + d]; last += tv; if (q < tq) off += tv; }
#pragma unroll
  for (int ii = 0; ii < 32; ++ii) {
    const int j = tq * 32 + ii;
    keT[d * 136 + j] = f2bf(kk[ii] * __expf(last - (off + cum[ii])));
    vT[d * 136 + j] = pv[ii];
  }
  if (tq == 0) p.dech[(size_t)item * 64 + d] = __expf(last);
  __syncthreads();
  f32x4 sacc[4];
#pragma unroll
  for (int di = 0; di < 4; ++di) { sacc[di][0] = 0.f; sacc[di][1] = 0.f; sacc[di][2] = 0.f; sacc[di][3] = 0.f; }
#pragma unroll
  for (int ks = 0; ks < 4; ++ks) {
    const bf16x8 a = *(const bf16x8*)(vT + (w * 16 + r16) * 136 + ks * 32 + q4 * 8);
#pragma unroll
    for (int di = 0; di < 4; ++di) {
      const bf16x8 bb = *(const bf16x8*)(keT + (di * 16 + r16) * 136 + ks * 32 + q4 * 8);
      sacc[di] = MFMA16(a, bb, sacc[di]);
    }
  }
  float* Est = p.Eh + (size_t)item * 4096;
#pragma unroll
  for (int di = 0; di < 4; ++di)
#pragma unroll
    for (int jj = 0; jj < 4; ++jj) Est[(w * 16 + q4 * 4 + jj) * 64 + di * 16 + r16] = sacc[di][jj];
  __syncthreads();
}

DI void phase_B(char* smem, const Params& p, int layer) {
  float* rs = (float*)(smem + 147456);
  const int J_E = 16 * 5, J_Q = 132 * 2, J_KV = 132 * 2, J_HG2 = NBATCH * 4 * 2 * NSC / 2;
  const float mscale = 0.10206207261596575f * LOG2E;
  const int G = gridDim.x;
  for (int j = bid_(); j < J_HG2; j += G) hg_state_item(smem, p, layer, j);
  for (int j = (bid_() + G - (J_HG2 % G)) % G; j < J_E; j += G) {
    const int g = j / 5, mt = j % 5;
    const bf16_t* Pu = p.Pu;
    auto al = [=](int row, int k) -> uint4 {
      row = min(row, NCHR - 1);
      return *(const uint4*)(Pu + ((size_t)row * 32 + (k >> 4)) * 256 + g * 16 + (k & 15));
    };
    float* Es5 = p.Es5;
    auto ep = [=](int row, int col, float v0, float v1, float v2, float v3) { if (row < NCHR) *(float4*)(Es5 + ((size_t)row * 16 + g) * 256 + col) = make_float4(v0, v1, v2, v3); };
    gemm_tile(smem, al, p.W1 + (size_t)(layer * 16 + g) * 256 * 512, 512, 256, ep, mt * 256, 0, 512);
  }
  for (int j = (bid_() + G - ((J_HG2 + J_E) % G)) % G; j < J_Q; j += G) {
    const int mt = j >> 1, nt = j & 1;
    row_rms(rs, p.Pm, 384, mt * 256, 256);
    const bf16_t* Pm = p.Pm;
    auto al = [=](int row, int k) -> uint4 { return *(const uint4*)(Pm + (size_t)row * 384 + k); };
    const float* ropeM = p.ropeM; bf16_t* Qm = p.Qm;
    auto ep = [=](int row, int col, float v0, float v1, float v2, float v3) {
      if (col >= 384) return;
      const int b = row / TT, t = row - b * TT;
      const int hd = col / 96, dd = col - hd * 96;
      const float rr = rs[row - mt * 256] * mscale;
      v0 *= rr; v1 *= rr; v2 *= rr; v3 *= rr;
      if (dd >= 64 && t >= CTXL) {
        const int e = dd - 64, pos = t - CTXL;
        const int a = e >> 4, f = (e & 15) >> 1;
        const int pa = a ? (pos & 63) : (pos >> 6);
        const float4 cs = *(const float4*)(ropeM + 2 * (pa * 8 + f));
        const float o0 = v0 * cs.x - v1 * cs.y, o1 = v1 * cs.x + v0 * cs.y;
        const float o2 = v2 * cs.z - v3 * cs.w, o3 = v3 * cs.z + v2 * cs.w;
        v0 = o0; v1 = o1; v2 = o2; v3 = o3;
      }
      *(uint2*)(Qm + ((size_t)(b * 4 + hd) * TT + t) * 96 + dd) = make_uint2(pack2(v0, v1), pack2(v2, v3));
    };
    gemm_tile_dma<4>(smem, p.Pm, 384, p.Wq + (size_t)layer * 384 * 256, 256, 384, ep, mt * 256, nt * 256, 256);
  }
  for (int j = (bid_() + G - ((J_HG2 + J_E + J_Q) % G)) % G; j < J_KV; j += G) {
    const int mt = j >> 1, nt = j & 1;
    row_rms(rs, p.Pm + 256, 384, mt * 256, 128);
    const bf16_t* Pm = p.Pm + 256;
    auto al = [=](int row, int k) -> uint4 { return *(const uint4*)(Pm + (size_t)row * 384 + k); };
    bf16_t* Km = p.Km; bf16_t* VmT = p.VmT;
    auto ep = [=](int row, int col, float v0, float v1, float v2, float v3) {
      const int b = row / TT, t = row - b * TT;
      const int hd = col >> 7, jj = col & 127;
      const float rr = rs[row - mt * 256];
      v0 *= rr; v1 *= rr; v2 *= rr; v3 *= rr;
      if (jj < 64) *(uint2*)(Km + ((size_t)(b * 4 + hd) * TT + t) * 96 + jj) = make_uint2(pack2(v0, v1), pack2(v2, v3));
      else {
        bf16_t* vp = VmT + ((size_t)(b * 4 + hd) * 64 + (jj - 64)) * TT + t;
        vp[0] = f2bf(v0); vp[TT] = f2bf(v1); vp[2 * TT] = f2bf(v2); vp[3 * TT] = f2bf(v3);
      }
    };
    gemm_tile_dma<4>(smem, p.Pm + 256, 384, p.Wkv + (size_t)layer * 512 * 128, 128, 512, ep, mt * 256, nt * 256, 128);
  }
}

template <int DQK, bool WINDOW>
DI void attn_item(char* smem, const bf16_t* __restrict__ Q, const bf16_t* __restrict__ K, const bf16_t* __restrict__ VT,
                  int qh, int kvh, int b, int q0, bool has_sink, float sink_l2, bf16_t* __restrict__ Y, int ycol) {
  constexpr int KS = DQK / 16, KSTR = DQK + 8, VSTR = 72, KV8 = DQK / 8;
  bf16_t* sK = (bf16_t*)smem;
  bf16_t* sV = sK + 64 * KSTR;
  const int tid = tid_(), w = tid >> 6, l = tid & 63, r = l & 31, h = l >> 5;
  bf16x8 qf[KS];
  {
    const bf16_t* qp = Q + ((size_t)qh * TT + q0 + w * 32 + r) * DQK + 8 * h;
#pragma unroll
    for (int ks = 0; ks < KS; ++ks) qf[ks] = *(const bf16x8*)(qp + ks * 16);
  }
  f32x16 o0, o1;
#pragma unroll
  for (int i = 0; i < 16; ++i) { o0[i] = 0; o1[i] = 0; }
  float m = 0.f, lsum = 0.f;
  int lo, hi;
  if (q0 < CTXL) { lo = CTXL; hi = CTXL; }
  else if (WINDOW) { lo = max(CTXL, q0 - 128); hi = min(TT, q0 + 256 + 128); }
  else { lo = CTXL; hi = TT; }
  const int ntiles = 4 + ((hi - lo) >> 6);
  const bf16_t* Kb = K + (size_t)kvh * TT * DQK;
  const bf16_t* Vb = VT + (size_t)kvh * 64 * TT;
  const int qpos = q0 + w * 32 + r;
  constexpr bool K2 = (64 * KV8) > NTHR;
  constexpr int BUFE = 64 * KSTR + 64 * VSTR;
  uint4 kr0, kr1, vr0;
  kr1 = make_uint4(0, 0, 0, 0);
  const int kidx1 = K2 ? min(tid + NTHR, 64 * KV8 - 1) : 0;
  const int krow0 = tid / KV8, kcc0 = tid - krow0 * KV8, krow1 = kidx1 / KV8, kcc1 = kidx1 - krow1 * KV8;
  const int vrow0 = tid >> 3, vcc0 = tid & 7;
#define TILE_K0(i) ((i) < 4 ? (i) * 64 : lo + ((i) - 4) * 64)
#define ALOAD(i) { const int kk0 = TILE_K0(i); \
    kr0 = *(const uint4*)(Kb + (size_t)(kk0 + krow0) * DQK + kcc0 * 8); \
    if (K2) kr1 = *(const uint4*)(Kb + (size_t)(kk0 + krow1) * DQK + kcc1 * 8); \
    vr0 = *(const uint4*)(Vb + (size_t)vrow0 * TT + kk0 + vcc0 * 8); }
#define ASTORE(bb) { bf16_t* dK = (bf16_t*)smem + (bb) * BUFE; bf16_t* dV = dK + 64 * KSTR; \
    *(uint4*)(dK + krow0 * KSTR + kcc0 * 8) = kr0; \
    if (K2) *(uint4*)(dK + krow1 * KSTR + kcc1 * 8) = kr1; \
    *(uint4*)(dV + vrow0 * VSTR + vcc0 * 8) = vr0; }
  ALOAD(0)
  __syncthreads();
  ASTORE(0)
  ALOAD(min(1, ntiles - 1))
  for (int it = 0; it < ntiles; ++it) {
    const int k0 = TILE_K0(it);
    __syncthreads();
    ASTORE((it + 1) & 1)
    __builtin_amdgcn_sched_barrier(0);
    ALOAD(min(it + 2, ntiles - 1))
    __builtin_amdgcn_sched_barrier(0);
    sK = (bf16_t*)smem + (it & 1) * BUFE;
    sV = sK + 64 * KSTR;
    f32x16 s0, s1;
    const float ninit = -m;
#pragma unroll
    for (int i = 0; i < 16; ++i) { s0[i] = ninit; s1[i] = ninit; }
#pragma unroll
    for (int ks = 0; ks < KS; ++ks) {
      bf16x8 a0 = *(const bf16x8*)(sK + r * KSTR + ks * 16 + 8 * h);
      bf16x8 a1 = *(const bf16x8*)(sK + (32 + r) * KSTR + ks * 16 + 8 * h);
      s0 = MFMA32(a0, qf[ks], s0);
      s1 = MFMA32(a1, qf[ks], s1);
    }
    if (WINDOW && k0 >= CTXL) {
#pragma unroll
      for (int i = 0; i < 16; ++i) {
        const int kp = k0 + crow(i, h);
        if (abs(qpos - kp) > 128) s0[i] = -1e30f;
        if (abs(qpos - kp - 32) > 128) s1[i] = -1e30f;
      }
    }
    int mxb = max(__float_as_int(s0[0]), __float_as_int(s1[0]));
#pragma unroll
    for (int i = 1; i < 16; ++i) mxb = max(mxb, max(__float_as_int(s0[i]), __float_as_int(s1[i])));
    if (__any((it == 0) || (mxb > 0x41000000))) {
      float mx = -1e30f;
#pragma unroll
      for (int i = 0; i < 16; ++i) mx = fmaxf(mx, fmaxf(s0[i], s1[i]));
      mx = fmaxf(mx, __shfl_xor(mx, 32, 64));
      const float delta = (it == 0) ? mx : fmaxf(mx, 0.f);
      const float alpha = (it == 0) ? 1.f : __builtin_amdgcn_exp2f(-delta);
      m += delta;
      lsum *= alpha;
#pragma unroll
      for (int i = 0; i < 16; ++i) { o0[i] *= alpha; o1[i] *= alpha; s0[i] -= delta; s1[i] -= delta; }
    }
    float rsum = 0;
#pragma unroll
    for (int i = 0; i < 16; ++i) { s0[i] = __builtin_amdgcn_exp2f(s0[i]); s1[i] = __builtin_amdgcn_exp2f(s1[i]); rsum += s0[i] + s1[i]; }
    rsum += __shfl_xor(rsum, 32, 64);
    lsum += rsum;
#pragma unroll
    for (int mt = 0; mt < 2; ++mt) {
#pragma unroll
      for (int s = 0; s < 2; ++s) {
        union { bf16x8 v; unsigned u[4]; } pk;
        if (mt == 0) {
          pk.u[0] = pack2(s0[8 * s + 0], s0[8 * s + 1]); pk.u[1] = pack2(s0[8 * s + 2], s0[8 * s + 3]);
          pk.u[2] = pack2(s0[8 * s + 4], s0[8 * s + 5]); pk.u[3] = pack2(s0[8 * s + 6], s0[8 * s + 7]);
        } else {
          pk.u[0] = pack2(s1[8 * s + 0], s1[8 * s + 1]); pk.u[1] = pack2(s1[8 * s + 2], s1[8 * s + 3]);
          pk.u[2] = pack2(s1[8 * s + 4], s1[8 * s + 5]); pk.u[3] = pack2(s1[8 * s + 6], s1[8 * s + 7]);
        }
        const int base = mt * 32 + s * 16 + 4 * h;
        union { bf16x8 v; uint2 u[2]; } va, vb;
        va.u[0] = *(const uint2*)(sV + r * VSTR + base);
        va.u[1] = *(const uint2*)(sV + r * VSTR + base + 8);
        vb.u[0] = *(const uint2*)(sV + (32 + r) * VSTR + base);
        vb.u[1] = *(const uint2*)(sV + (32 + r) * VSTR + base + 8);
        o0 = MFMA32(va.v, pk.v, o0);
        o1 = MFMA32(vb.v, pk.v, o1);
      }
    }
  }
#undef TILE_K0
#undef ALOAD
#undef ASTORE
  float lt = lsum;
  if (has_sink) lt += __builtin_amdgcn_exp2f(sink_l2 - m);
  const float inv = 1.f / lt;
  bf16_t* yp = Y + ((size_t)b * TT + qpos) * DM + ycol;
#pragma unroll
  for (int g = 0; g < 4; ++g) {
    uint2 u0, u1;
    u0.x = pack2(o0[4 * g] * inv, o0[4 * g + 1] * inv); u0.y = pack2(o0[4 * g + 2] * inv, o0[4 * g + 3] * inv);
    u1.x = pack2(o1[4 * g] * inv, o1[4 * g + 1] * inv); u1.y = pack2(o1[4 * g + 2] * inv, o1[4 * g + 3] * inv);
    *(uint2*)(yp + 8 * g + 4 * h) = u0;
    *(uint2*)(yp + 32 + 8 * g + 4 * h) = u1;
  }
}

template <int DQK>
DI void attn_item2(char* smem, const bf16_t* __restrict__ Q, const bf16_t* __restrict__ K, const bf16_t* __restrict__ VT,
                   int qh, int kvh, int b, int q0, bf16_t* __restrict__ Y, int ycol) {
  constexpr int KS = DQK / 16, KSTR = DQK + 8, VSTR = 72, KV8 = DQK / 8;
  const int tid = tid_(), w = tid >> 6, l = tid & 63, r = l & 31, h = l >> 5;
  bf16x8 qf[2][KS];
#pragma unroll
  for (int qn = 0; qn < 2; ++qn) {
    const bf16_t* qp = Q + ((size_t)qh * TT + q0 + w * 64 + qn * 32 + r) * DQK + 8 * h;
#pragma unroll
    for (int ks = 0; ks < KS; ++ks) qf[qn][ks] = *(const bf16x8*)(qp + ks * 16);
  }
  f32x16 o[2][2];
#pragma unroll
  for (int qn = 0; qn < 2; ++qn)
#pragma unroll
    for (int i = 0; i < 16; ++i) { o[qn][0][i] = 0; o[qn][1][i] = 0; }
  float m[2] = {0.f, 0.f}, lsum[2] = {0.f, 0.f};
  const int ntiles = TT / 64;
  const bf16_t* Kb = K + (size_t)kvh * TT * DQK;
  const bf16_t* Vb = VT + (size_t)kvh * 64 * TT;
  constexpr bool K2 = (64 * KV8) > NTHR;
  constexpr int BUFE = 64 * KSTR + 64 * VSTR;
  uint4 kr0, kr1, vr0;
  kr1 = make_uint4(0, 0, 0, 0);
  const int kidx1 = K2 ? min(tid + NTHR, 64 * KV8 - 1) : 0;
  const int krow0 = tid / KV8, kcc0 = tid - krow0 * KV8, krow1 = kidx1 / KV8, kcc1 = kidx1 - krow1 * KV8;
  const int vrow0 = tid >> 3, vcc0 = tid & 7;
#define ALOAD(i) { const int kk0 = (i) * 64; \
    kr0 = *(const uint4*)(Kb + (size_t)(kk0 + krow0) * DQK + kcc0 * 8); \
    if (K2) kr1 = *(const uint4*)(Kb + (size_t)(kk0 + krow1) * DQK + kcc1 * 8); \
    vr0 = *(const uint4*)(Vb + (size_t)vrow0 * TT + kk0 + vcc0 * 8); }
#define ASTORE(bb) { bf16_t* dK = (bf16_t*)smem + (bb) * BUFE; bf16_t* dV = dK + 64 * KSTR; \
    *(uint4*)(dK + krow0 * KSTR + kcc0 * 8) = kr0; \
    if (K2) *(uint4*)(dK + krow1 * KSTR + kcc1 * 8) = kr1; \
    *(uint4*)(dV + vrow0 * VSTR + vcc0 * 8) = vr0; }
  ALOAD(0)
  __syncthreads();
  ASTORE(0)
  ALOAD(1)
  for (int it = 0; it < ntiles; ++it) {
    __syncthreads();
    ASTORE((it + 1) & 1)
    __builtin_amdgcn_sched_barrier(0);
    ALOAD(min(it + 2, ntiles - 1))
    __builtin_amdgcn_sched_barrier(0);
    const bf16_t* sK = (const bf16_t*)smem + (it & 1) * BUFE;
    const bf16_t* sV = sK + 64 * KSTR;
    f32x16 s[2][2];
#pragma unroll
    for (int qn = 0; qn < 2; ++qn) {
      const float ninit = -m[qn];
#pragma unroll
      for (int i = 0; i < 16; ++i) { s[qn][0][i] = ninit; s[qn][1][i] = ninit; }
    }
#pragma unroll
    for (int ks = 0; ks < KS; ++ks) {
      bf16x8 a0 = *(const bf16x8*)(sK + r * KSTR + ks * 16 + 8 * h);
      bf16x8 a1 = *(const bf16x8*)(sK + (32 + r) * KSTR + ks * 16 + 8 * h);
#pragma unroll
      for (int qn = 0; qn < 2; ++qn) {
        s[qn][0] = MFMA32(a0, qf[qn][ks], s[qn][0]);
        s[qn][1] = MFMA32(a1, qf[qn][ks], s[qn][1]);
      }
    }
    int mxb = __float_as_int(s[0][0][0]);
#pragma unroll
    for (int qn = 0; qn < 2; ++qn)
#pragma unroll
      for (int i = 0; i < 16; ++i) mxb = max(mxb, max(__float_as_int(s[qn][0][i]), __float_as_int(s[qn][1][i])));
    if (__any((it == 0) || (mxb > 0x41000000))) {
#pragma unroll
      for (int qn = 0; qn < 2; ++qn) {
        float mx = -1e30f;
#pragma unroll
        for (int i = 0; i < 16; ++i) mx = fmaxf(mx, fmaxf(s[qn][0][i], s[qn][1][i]));
        mx = fmaxf(mx, __shfl_xor(mx, 32, 64));
        const float delta = (it == 0) ? mx : fmaxf(mx, 0.f);
        const float alpha = (it == 0) ? 1.f : __builtin_amdgcn_exp2f(-delta);
        m[qn] += delta;
        lsum[qn] *= alpha;
#pragma unroll
        for (int i = 0; i < 16; ++i) { o[qn][0][i] *= alpha; o[qn][1][i] *= alpha; s[qn][0][i] -= delta; s[qn][1][i] -= delta; }
      }
    }
#pragma unroll
    for (int mt = 0; mt < 2; ++mt) {
#pragma unroll
      for (int qn = 0; qn < 2; ++qn) {
        float rsum = 0;
#pragma unroll
        for (int i = 0; i < 16; ++i) { s[qn][mt][i] = __builtin_amdgcn_exp2f(s[qn][mt][i]); rsum += s[qn][mt][i]; }
        lsum[qn] += rsum;
      }
#pragma unroll
      for (int sx = 0; sx < 2; ++sx) {
        const int base = mt * 32 + sx * 16 + 4 * h;
        union { bf16x8 v; uint2 u[2]; } va, vb;
        va.u[0] = *(const uint2*)(sV + r * VSTR + base);
        va.u[1] = *(const uint2*)(sV + r * VSTR + base + 8);
        vb.u[0] = *(const uint2*)(sV + (32 + r) * VSTR + base);
        vb.u[1] = *(const uint2*)(sV + (32 + r) * VSTR + base + 8);
#pragma unroll
        for (int qn = 0; qn < 2; ++qn) {
          union { bf16x8 v; unsigned u[4]; } pk;
          pk.u[0] = pack2(s[qn][mt][8 * sx + 0], s[qn][mt][8 * sx + 1]); pk.u[1] = pack2(s[qn][mt][8 * sx + 2], s[qn][mt][8 * sx + 3]);
          pk.u[2] = pack2(s[qn][mt][8 * sx + 4], s[qn][mt][8 * sx + 5]); pk.u[3] = pack2(s[qn][mt][8 * sx + 6], s[qn][mt][8 * sx + 7]);
          o[qn][0] = MFMA32(va.v, pk.v, o[qn][0]);
          o[qn][1] = MFMA32(vb.v, pk.v, o[qn][1]);
        }
      }
    }
  }
#undef ALOAD
#undef ASTORE
#pragma unroll
  for (int qn = 0; qn < 2; ++qn) {
    const float lt = lsum[qn] + __shfl_xor(lsum[qn], 32, 64);
    const float inv = 1.f / lt;
    bf16_t* yp = Y + ((size_t)b * TT + q0 + w * 64 + qn * 32 + r) * DM + ycol;
#pragma unroll
    for (int g = 0; g < 4; ++g) {
      uint2 u0, u1;
      u0.x = pack2(o[qn][0][4 * g] * inv, o[qn][0][4 * g + 1] * inv); u0.y = pack2(o[qn][0][4 * g + 2] * inv, o[qn][0][4 * g + 3] * inv);
      u1.x = pack2(o[qn][1][4 * g] * inv, o[qn][1][4 * g + 1] * inv); u1.y = pack2(o[qn][1][4 * g + 2] * inv, o[qn][1][4 * g + 3] * inv);
      *(uint2*)(yp + 8 * g + 4 * h) = u0;
      *(uint2*)(yp + 32 + 8 * g + 4 * h) = u1;
    }
  }
}

DI void phase_C(char* smem, const Params& p, int layer) {
  const int J_S5 = 16, J_HG = 256, J_SWA = NBATCH * 4 * 33;
  const int G = gridDim.x;
  for (int j = bid_(); j < J_S5; j += G) {
    const int gid = j * NTHR + tid_();
    const int pp = gid & 63, dirn = (gid >> 6) & 1, g = (gid >> 7) & 15, b = gid >> 11;
    const int jb = (layer * 2 + dirn) * 16 + g;
    const float ar = p.apow[((size_t)jb * 33 + 32) * 128 + pp * 2], ai = p.apow[((size_t)jb * 33 + 32) * 128 + pp * 2 + 1];
    float sr = 0, si = 0;
    float* base = p.Es5 + ((size_t)b * NCH * 16 + g) * 256 + dirn * 128 + pp * 2;
#define MCH(n) (dirn == 0 ? (n) : ((n) < 8 ? 7 - (n) : 271 - (n)))
#pragma unroll 1
    for (int n0 = 0; n0 < NCH; n0 += 44) {
      float2 e[44];
#pragma unroll
      for (int u = 0; u < 44; ++u) e[u] = *(const float2*)(base + (size_t)MCH(n0 + u) * 4096);
#pragma unroll
      for (int u = 0; u < 44; ++u) {
        *(float2*)(base + (size_t)MCH(n0 + u) * 4096) = make_float2(sr, si);
        const float nr = ar * sr - ai * si + e[u].x, ni = ar * si + ai * sr + e[u].y;
        sr = nr; si = ni;
      }
    }
#undef MCH
  }
  for (int j = bid_(); j < J_HG; j += G) {
    const int gid = j * NTHR + tid_();
    const int chain = gid >> 12, e = gid & 4095, d = e & 63;
    float* base = p.Eh + (size_t)chain * NSC * 4096 + e;
    const float* db = p.dech + (size_t)chain * NSC * 64 + d;
    float s = 0;
#pragma unroll 1
    for (int n0 = 0; n0 < NSC; n0 += 22) {
      float ev[22], dv[22];
#pragma unroll
      for (int u = 0; u < 22; ++u) { ev[u] = base[(size_t)(n0 + u) * 4096]; dv[u] = db[(n0 + u) * 64]; }
#pragma unroll
      for (int u = 0; u < 22; ++u) { base[(size_t)(n0 + u) * 4096] = s; s = dv[u] * s + ev[u]; }
    }
  }
  {
    const int nb = G > 32 ? G - 16 : G, me = G > 32 ? bid_() - 16 : bid_();
    if (me >= 0) {
      for (int j = me; j < J_SWA; j += nb) {
        const int qt = j % 33, bh = j / 33, hd = bh & 3, b = bh >> 2;
        attn_item<64, true>(smem, p.Qs, p.Ks, p.VsT, b * 4 + hd, b * 2 + (hd >> 1), b, qt * 256, true,
                            p.sink[layer * 4 + hd] * LOG2E, p.Hn, 256 + hd * 64);
      }
    }
  }
}

DI void phase_D(char* smem, const Params& p, int layer) {
  const int J_MLA = 256 + 16, J_RD = 16 * 5 * 2, J_HG = NBATCH * 4 * 2 * NSC / 2;
  const int G = gridDim.x;
  for (int j = bid_(); j < J_MLA; j += G) {
    if (j < 256) {
      const int rest = j >> 3, bh = (j & 7) + 8 * (rest >> 4), qt = rest & 15;
      attn_item2<96>(smem, p.Qm, p.Km, p.VmT, bh, bh, bh >> 2, CTXL + qt * 512, p.Hn, 768 + (bh & 3) * 64);
    } else {
      const int bh = j - 256;
      attn_item<96, false>(smem, p.Qm, p.Km, p.VmT, bh, bh, bh >> 2, 0, false, 0.f, p.Hn, 768 + (bh & 3) * 64);
    }
  }
  for (int j = (bid_() + G - (J_MLA % G)) % G; j < J_RD; j += G) {
    const int g = j / 10, q = j % 10, mt = q >> 1, nt = q & 1;
    const bf16_t* Pu = p.Pu; const float* Es = p.Es5;
    auto al = [=](int row, int k) -> uint4 {
      row = min(row, NCHR - 1);
      if (k < 512) return *(const uint4*)(Pu + ((size_t)row * 32 + (k >> 4)) * 256 + g * 16 + (k & 15));
      const float* e = Es + ((size_t)row * 16 + g) * 256 + (k - 512);
      float4 a = *(const float4*)e, c = *(const float4*)(e + 4);
      return make_uint4(pack2(a.x, a.y), pack2(a.z, a.w), pack2(c.x, c.y), pack2(c.z, c.w));
    };
    bf16_t* Yg = p.Yg;
    auto ep = [=](int row, int col, float v0, float v1, float v2, float v3) {
      if (row >= NCHR) return;
      const int t = col >> 4, hh = col & 15;
      auto gelu = [](float v) {
        const float u = 0.7978845608028654f * (v + 0.044715f * v * v * v);
        const float th = 1.f - 2.f * __builtin_amdgcn_rcpf(1.f + __expf(2.f * u));
        return 0.5f * v * (1.f + th);
      };
      *(uint2*)(Yg + ((size_t)row * 32 + t) * 256 + g * 16 + hh) = make_uint2(pack2(gelu(v0), gelu(v1)), pack2(gelu(v2), gelu(v3)));
    };
    gemm_tile(smem, al, p.TW + (size_t)(layer * 16 + g) * 512 * 768, 768, 512, ep, mt * 256, nt * 256, 768);
  }
  for (int j = (bid_() + G - ((J_MLA + J_RD) % G)) % G; j < J_HG; j += G) hg_item<true>(smem, p, layer, j);
}

DI void phase_E(char* smem, const Params& p, int layer) {
  const int J_GLU = 132, J_FIN = R / 16;
  const int G = gridDim.x;
  for (int j = bid_(); j < J_GLU; j += G) {
    const int mt = j, nt = 0;
    const bf16_t* Yg = p.Yg; bf16_t* Hn = p.Hn; const float* bg = p.b_glu + layer * 256;
    auto al = [=](int row, int k) -> uint4 { return *(const uint4*)(Yg + (size_t)row * 256 + k); };
    auto ep = [=](int row, int col, float v0, float v1, float v2, float v3) {
      const uint2 yy = *(const uint2*)(Yg + (size_t)row * 256 + col);
      const float4 bb = *(const float4*)(bg + col);
      const float y0 = __uint_as_float(yy.x << 16), y1 = __uint_as_float(yy.x & 0xffff0000u);
      const float y2 = __uint_as_float(yy.y << 16), y3 = __uint_as_float(yy.y & 0xffff0000u);
      *(uint2*)(Hn + (size_t)row * DM + col) = make_uint2(pack2(y0 * fsigmoid(v0 + bb.x), y1 * fsigmoid(v1 + bb.y)),
                                                         pack2(y2 * fsigmoid(v2 + bb.z), y3 * fsigmoid(v3 + bb.w)));
    };
    gemm_tile_dma<4>(smem, p.Yg, 256, p.Wg + (size_t)layer * 65536, 256, 256, ep, mt * 256, nt * 256, 256);
  }
  for (int j = (bid_() + G - (J_GLU % G)) % G; j < J_FIN; j += G) {
    const int w = (tid_() >> 6) & 3, rsel = tid_() >> 8, l = tid_() & 63;
    const float gn = p.hg_norm_g[layer * 64 + l];
#pragma unroll
    for (int rr = 0; rr < 8; ++rr) {
      const int row = j * 16 + rr * 2 + rsel;
      const float o = bf2f(p.OF[(size_t)row * 256 + w * 64 + l]) + bf2f(p.OB[(size_t)row * 256 + w * 64 + l]);
      const float ss = wave_sum(o * o);
      const float rs = rsqrtf(ss * (1.f / 64.f) + EPSN);
      const float gt = bf2f(p.PH[(size_t)row * 1280 + 1024 + w * 64 + l]);
      p.Hn[(size_t)row * DM + 512 + w * 64 + l] = f2bf(o * rs * gn * gt * sigmoidf_(gt));
    }
  }
}

DI void phase_resid(char* smem, const Params& p, int layer, const bf16_t* A, int K, const bf16_t* W, int gate_idx, bool first) {
  auto al = [=](int row, int k) -> uint4 { return *(const uint4*)(A + (size_t)row * K + k); };
  auto ep = [&](int row, int col, float v0, float v1, float v2, float v3) {
    const int b = row / TT, t = row - b * TT;
    const float4 g = *(const float4*)(p.mod + (size_t)(layer * 5 + (t < CTXL ? 4 : b)) * 6144 + gate_idx * 1024 + col);
    const float4 xo = *(const float4*)(xsrc_row(p, first, row) + col);
    *(float4*)(xdst_row(p, row) + col) = make_float4(xo.x + g.x * v0, xo.y + g.y * v1, xo.z + g.z * v2, xo.w + g.w * v3);
  };
  for_tiles_xcd<1>(R / 256, 4, [&](int m0, int nt, auto mi) { gemm_tile_dma<decltype(mi)::value>(smem, A, K, W, K, DM, ep, m0, nt * 256, K); });
}

DI void phase_ffn_up(char* smem, const Params& p, int layer) {
  const bf16_t* Hn = p.Hn;
  auto al = [=](int row, int k) -> uint4 { return *(const uint4*)(Hn + (size_t)row * DM + k); };
  bf16_t* Hh = p.H;
  auto ep = [=](int row, int cb, int q4, const f32x4& c0, const f32x4& c1, const f32x4& c2, const f32x4& c3) {
    const uint4 o = make_uint4(pack2(c0[0] * fsigmoid(c0[0]) * c0[1], c0[2] * fsigmoid(c0[2]) * c0[3]),
                               pack2(c1[0] * fsigmoid(c1[0]) * c1[1], c1[2] * fsigmoid(c1[2]) * c1[3]),
                               pack2(c2[0] * fsigmoid(c2[0]) * c2[1], c2[2] * fsigmoid(c2[2]) * c2[3]),
                               pack2(c3[0] * fsigmoid(c3[0]) * c3[1], c3[2] * fsigmoid(c3[2]) * c3[3]));
    *(uint4*)(Hh + (size_t)row * FH + (cb >> 1) + q4 * 8) = o;
  };
  const bf16_t* W = p.Wu + (size_t)layer * 2 * FH * DM;
  for_tiles_xcd<2>(R / 256, 22, [&](int m0, int nt, auto mi) { gemm_tile_dma<decltype(mi)::value>(smem, Hn, DM, W, DM, 2 * FH, ep, m0, nt * 256, DM); });
}

constexpr int N_PHASES = 2 + 10 * DEPTH;

__global__ void __launch_bounds__(512, 2) mega(Params p, int ph_lo, int ph_hi) {
  extern __shared__ __attribute__((aligned(16))) char smem[];
  for (int ph = ph_lo; ph < ph_hi; ++ph) {
    if (ph == 0) phase_prep(smem, p);
    else if (ph == 1) { phase_s5mats(p); phase_norm(p, 0, 0, true); }
    else {
      const int layer = (ph - 2) / 10, s = (ph - 2) % 10;
      const bool first = layer == 0;
      switch (s) {
        case 0: phase_win(smem, p, layer); break;
        case 1: phase_B(smem, p, layer); break;
        case 2: phase_C(smem, p, layer); break;
        case 3: phase_D(smem, p, layer); break;
        case 4: phase_E(smem, p, layer); break;
        case 5: phase_resid(smem, p, layer, p.Hn, DM, p.Wo + (size_t)layer * DM * DM, 2, first); break;
        case 6: phase_norm(p, layer, 1, false); break;
        case 7: phase_ffn_up(smem, p, layer); break;
        case 8: phase_resid(smem, p, layer, p.H, FH, p.Wd + (size_t)layer * DM * FH, 5, false); break;
        default:
          if (layer + 1 < DEPTH) phase_norm(p, layer + 1, 0, false); else phase_final_norm(p);
          break;
      }
    }
    if (ph + 1 < ph_hi) grid_barrier(p.bar, (unsigned)(ph - ph_lo + 1));
  }
}

extern "C" void kernel_launch(void* const* d_in, const int* in_sizes, int n_in, void* d_out, int out_size, void* d_ws,
                              size_t ws_size, hipStream_t stream) {
  static int grid_blocks = 0;
  if (!grid_blocks) {
    int dev = 0, cus = 0, per_cu = 0;
    hipGetDevice(&dev);
    hipDeviceGetAttribute(&cus, hipDeviceAttributeMultiprocessorCount, dev);
    hipFuncSetAttribute((const void*)mega, hipFuncAttributeMaxDynamicSharedMemorySize, LDS_BYTES);
    hipOccupancyMaxActiveBlocksPerMultiprocessor(&per_cu, (const void*)mega, NTHR, LDS_BYTES);
    (void)per_cu;
    grid_blocks = cus;
  }
  Params p{};
  const float** ins = (const float**)&p;
  for (int i = 0; i < 30; ++i) ins[i] = (const float*)d_in[i];
  p.out = (float*)d_out;
  char* ws = (char*)d_ws;
  size_t off = 0;
  auto take = [&](size_t bytes) { char* q = ws + off; off += (bytes + 255) & ~(size_t)255; return q; };
  p.bar = (unsigned*)take(8192);
  p.Xc = (float*)take((size_t)NBATCH * CTXL * DM * 4);
  p.mod = (float*)take((size_t)DEPTH * 5 * 6144 * 4);
  p.lb = (float*)take(2 * 4 * 256 * 4);
  p.ropeS = (float*)take(128 * 16 * 2 * 4);
  p.ropeM = (float*)take(128 * 8 * 2 * 4);
  p.apow = (float*)take((size_t)J_S5TAB * 33 * 128 * 4);
  p.bbar = (float*)take((size_t)J_S5TAB * 64 * 16 * 2 * 4);
  p.Ktab = (float*)take((size_t)J_S5TAB * 32 * 256 * 4);
  p.Wi = (bf16_t*)take((size_t)DEPTH * NINP * DM * 2);
  p.Wo = (bf16_t*)take((size_t)DEPTH * DM * DM * 2);
  p.Wu = (bf16_t*)take((size_t)DEPTH * 2 * FH * DM * 2);
  p.Wd = (bf16_t*)take((size_t)DEPTH * DM * FH * 2);
  p.Wg = (bf16_t*)take((size_t)DEPTH * 65536 * 2);
  p.Wq = (bf16_t*)take((size_t)DEPTH * 384 * 256 * 2);
  p.Wkv = (bf16_t*)take((size_t)DEPTH * 512 * 128 * 2);
  p.TW = (bf16_t*)take((size_t)DEPTH * 16 * 512 * 768 * 2);
  p.W1 = (bf16_t*)take((size_t)DEPTH * 16 * 256 * 512 * 2);
  p.Hn = (bf16_t*)take((size_t)R * DM * 2);
  const size_t big0 = off;
  p.Pu = (bf16_t*)take((size_t)R * 256 * 2);
  p.PH = (bf16_t*)take((size_t)R * 1280 * 2);
  p.Es5 = (float*)take((size_t)NCHR * 16 * 256 * 4);
  p.Eh = (float*)take((size_t)NBATCH * 4 * 2 * NSC * 4096 * 4);
  p.dech = (float*)take((size_t)NBATCH * 4 * 2 * NSC * 64 * 4);
  p.Qm = (bf16_t*)take((size_t)R * 4 * 96 * 2);
  p.Km = (bf16_t*)take((size_t)R * 4 * 96 * 2);
  p.VmT = (bf16_t*)take((size_t)R * 256 * 2);
  const size_t al0 = off;
  p.Pm = (bf16_t*)take((size_t)R * 384 * 2);
  p.Qs = (bf16_t*)take((size_t)R * 256 * 2);
  p.Ks = (bf16_t*)take((size_t)R * 128 * 2);
  p.VsT = (bf16_t*)take((size_t)R * 128 * 2);
  const size_t end1 = off;
  off = al0;
  p.Yg = (bf16_t*)take((size_t)R * 256 * 2);
  p.OF = (bf16_t*)take((size_t)R * 256 * 2);
  p.OB = (bf16_t*)take((size_t)R * 256 * 2);
  size_t end2 = off;
  p.H = (bf16_t*)(ws + big0);
  size_t endH = big0 + (size_t)R * FH * 2;
  size_t total = end1 > end2 ? end1 : end2;
  if (endH > total) total = endH;
  if (total > ws_size) { fprintf(stderr, "kernel_launch: workspace too small: need %zu, have %zu\n", total, ws_size); return; }
  if (hipMemsetAsync(p.bar, 0, 8192, stream) != hipSuccess) { fprintf(stderr, "memset failed\n"); return; }
  int lo = 0, hi = N_PHASES;
  void* args[] = {&p, &lo, &hi};
  hipError_t e = hipLaunchCooperativeKernel((const void*)mega, dim3(grid_blocks), dim3(NTHR), args, LDS_BYTES, stream);
  if (e != hipSuccess) fprintf(stderr, "cooperative launch failed: %s (grid %d)\n", hipGetErrorString(e), grid_blocks);
}
```

```cpp
#include <hip/hip_runtime.h>
#include <hip/hip_cooperative_groups.h>
#include <cstdio>
#include <type_traits>
namespace cg = cooperative_groups;

#define DI __device__ __forceinline__
typedef unsigned short bf16_t;
using bf16x8 = __attribute__((ext_vector_type(8))) short;
using f32x16 = __attribute__((ext_vector_type(16))) float;
using f32x4  = __attribute__((ext_vector_type(4))) float;

constexpr int DM = 1024, NBATCH = 4, SEQ = 8192, CTXL = 256, TT = SEQ + CTXL, R = NBATCH * TT, DEPTH = 4;
constexpr int NIN = 2464, FH = 2816;
constexpr int NINP = 2496;
constexpr int NCH = TT / 32;
constexpr int NCHR = NBATCH * NCH;
constexpr int NSC = TT / 128;
constexpr float LOG2E = 1.4426950408889634f;
constexpr float EPSN = 1e-6f;
constexpr int NTHR = 512;
constexpr int LDS_BYTES = 147456 + 1024;

#define MFMA32(a, b, c) __builtin_amdgcn_mfma_f32_32x32x16_bf16((a), (b), (c), 0, 0, 0)
#define MFMA16(a, b, c) __builtin_amdgcn_mfma_f32_16x16x32_bf16((a), (b), (c), 0, 0, 0)

DI int tid_() { int t = threadIdx.x; asm volatile("" : "+v"(t)); return t; }
DI int bid_() { int b = blockIdx.x; asm volatile("" : "+s"(b)); return b; }
typedef __bf16 hwbf2_t __attribute__((ext_vector_type(2)));
typedef float hwf2_t __attribute__((ext_vector_type(2)));
DI unsigned pack2(float a, float b) { hwf2_t f = {a, b}; return __builtin_bit_cast(unsigned, __builtin_convertvector(f, hwbf2_t)); }
DI bf16_t f2bf(float x) { return (bf16_t)(pack2(x, 0.f) & 0xffffu); }
DI float bf2f(bf16_t b) { return __uint_as_float(((unsigned)b) << 16); }
DI int crow(int reg, int h) { return (reg & 3) + 8 * (reg >> 2) + 4 * h; }
DI float sigmoidf_(float x) { return 1.f / (1.f + expf(-x)); }
DI float fsigmoid(float x) { return __builtin_amdgcn_rcpf(1.f + __expf(-x)); }
DI float wave_sum(float v) {
#pragma unroll
  for (int o = 32; o > 0; o >>= 1) v += __shfl_xor(v, o, 64);
  return v;
}


DI void my_sincos(float x, float* sn, float* cs) {
  const float q = rintf(x * 0.6366197723675814f);
  float r = fmaf(-q, 1.5707962512969971f, x);
  r = fmaf(-q, 7.549789415861596e-08f, r);
  r = fmaf(-q, 5.390302529957765e-15f, r);
  const float r2 = r * r;
  const float sp = r + r * r2 * (-1.6666667e-1f + r2 * (8.3333333e-3f + r2 * (-1.98412698e-4f + r2 * 2.7557319e-6f)));
  const float cp = 1.f + r2 * (-0.5f + r2 * (4.1666667e-2f + r2 * (-1.3888889e-3f + r2 * (2.48015873e-5f - r2 * 2.7557319e-7f))));
  const int qi = ((int)q) & 3;
  const float s_ = (qi & 1) ? cp : sp, c_ = (qi & 1) ? sp : cp;
  *sn = (qi < 2) ? s_ : -s_;
  *cs = (qi == 0 || qi == 3) ? c_ : -c_;
}

struct Params {
  const float *x, *c, *ctx, *c_ctx, *w_mod, *b_mod, *norm1_g, *norm2_g, *w_in, *w_out;
  const float *lam_re, *lam_im, *log_dt, *b_re, *b_im, *c_re, *c_im, *s5_d, *w_glu, *b_glu;
  const float *sink, *hg_lb, *hg_norm_g, *q_norm_g, *w_qb, *kv_norm_g, *w_kvb, *w_up, *w_down, *final_g;
  float* out;
  float *Xc, *mod, *lb, *ropeS, *ropeM, *apow, *bbar, *Ktab;
  bf16_t *Wi, *Wo, *Wu, *Wd, *Wg, *Wq, *Wkv, *TW, *W1;
  bf16_t *Hn;
  bf16_t *H;
  bf16_t *Pu, *PH, *Pm, *Qs, *Ks, *VsT, *Qm, *Km, *VmT, *Yg, *OF, *OB;
  float *Es5, *Eh, *dech;
  unsigned* bar;
};


DI void grid_barrier(unsigned* bar, unsigned ep) {
  asm volatile("s_waitcnt vmcnt(0)" ::: "memory");
  __syncthreads();
  if (threadIdx.x == 0) {
    const unsigned G = gridDim.x, g = blockIdx.x & 7u, nloc = (G - g + 7u) >> 3, ng = G < 8u ? G : 8u;
    __builtin_amdgcn_fence(__ATOMIC_RELEASE, "agent");
    asm volatile("s_waitcnt vmcnt(0)" ::: "memory");
    const unsigned old = __hip_atomic_fetch_add(&bar[64 * g], 1u, __ATOMIC_RELAXED, __HIP_MEMORY_SCOPE_AGENT);
    if (old + 1u == ep * nloc) {
      const unsigned og = __hip_atomic_fetch_add(&bar[1024], 1u, __ATOMIC_RELAXED, __HIP_MEMORY_SCOPE_AGENT);
      if (og + 1u == ep * ng) __hip_atomic_store(&bar[1088], ep, __ATOMIC_RELAXED, __HIP_MEMORY_SCOPE_AGENT);
      else while (__hip_atomic_load(&bar[1088], __ATOMIC_RELAXED, __HIP_MEMORY_SCOPE_AGENT) < ep) __builtin_amdgcn_s_sleep(1);
      __hip_atomic_store(&bar[512 + 64 * g], ep, __ATOMIC_RELAXED, __HIP_MEMORY_SCOPE_AGENT);
    } else {
      while (__hip_atomic_load(&bar[512 + 64 * g], __ATOMIC_RELAXED, __HIP_MEMORY_SCOPE_AGENT) < ep) __builtin_amdgcn_s_sleep(1);
    }
    __builtin_amdgcn_fence(__ATOMIC_ACQUIRE, "agent");
    asm volatile("s_waitcnt vmcnt(0)" ::: "memory");
  }
  __syncthreads();
}

DI const float* xsrc_row(const Params& p, bool first, int row) {
  int b = row / TT, t = row - b * TT;
  if (t < CTXL) return (first ? p.ctx : p.Xc) + ((size_t)b * CTXL + t) * DM;
  return (first ? p.x : p.out) + ((size_t)b * SEQ + (t - CTXL)) * DM;
}
DI float* xdst_row(const Params& p, int row) {
  int b = row / TT, t = row - b * TT;
  if (t < CTXL) return p.Xc + ((size_t)b * CTXL + t) * DM;
  return p.out + ((size_t)b * SEQ + (t - CTXL)) * DM;
}

DI int perm_col(int kind, int n) {
  if (kind == 0) {
    { const int c = n & 63; n = (n & ~63) + ((c >> 2) & 3) * 16 + ((c >> 4) & 3) * 4 + (c & 3); }
    if (n >= NIN) return -1;
    if (n >= 256 && n < 640) { int base = n & ~63, d = n & 63; int a = d >> 5, f = (d & 31) >> 1, hf = d & 1; return base + a * 32 + hf * 16 + f; }
    if (n >= 2432) { int e = n - 2432; int a = e >> 4, f = (e & 15) >> 1, hf = e & 1; return 2432 + a * 16 + hf * 8 + f; }
    return n;
  } else if (kind == 1) {
    int hd = n / 96, dd = n - hd * 96;
    if (dd >= 64) { int e = dd - 64; int a = e >> 4, f = (e & 15) >> 1, hf = e & 1; dd = 64 + a * 16 + hf * 8 + f; }
    return hd * 96 + dd;
  } else if (kind == 2) {
    const int grp = n >> 6, c = n & 63;
    const int nt = (c >> 4) & 3, q4 = (c >> 2) & 3, jj = c & 3;
    return (jj & 1) * FH + grp * 32 + q4 * 8 + nt * 2 + (jj >> 1);
  }
  return n;
}

template <int KT>
DI void conv_tile(float* tile, const float* __restrict__ src, int ldsrc, const float* __restrict__ rscale,
                  bf16_t* __restrict__ dst, int K, int n0, int k0, int kind) {
  const int j = tid_() & 31, i = tid_() >> 5;
  const int sc0 = perm_col(kind, n0 + j);
  const int sc = max(sc0, 0);
  const float scm = sc0 >= 0 ? 1.f : 0.f;
  constexpr int NL = KT / 16;
  float v[NL];
#pragma unroll
  for (int e = 0; e < NL; ++e) v[e] = src[(size_t)(k0 + i + 16 * e) * ldsrc + sc] * scm;
  if (rscale) {
#pragma unroll
    for (int e = 0; e < NL; ++e) v[e] *= rscale[k0 + i + 16 * e];
  }
#pragma unroll
  for (int e = 0; e < NL; ++e) tile[(i + 16 * e) * 33 + j] = v[e];
  __syncthreads();
  const int nn = tid_() >> 4, kq = (tid_() & 15) * 8;
#pragma unroll
  for (int ps = 0; ps < KT / 128; ++ps) {
    float o[8];
#pragma unroll
    for (int e = 0; e < 8; ++e) o[e] = tile[(ps * 128 + kq + e) * 33 + nn];
    *(uint4*)(dst + (size_t)(n0 + nn) * K + k0 + ps * 128 + kq) = make_uint4(pack2(o[0], o[1]), pack2(o[2], o[3]), pack2(o[4], o[5]), pack2(o[6], o[7]));
  }
  __syncthreads();
}

DI void mod_job(float* red, const float* __restrict__ sil, const Params& p, int jm) {
  const int l = jm / 192, cb = (jm % 192) * 32;
  const int j = tid_() & 31, ks = tid_() >> 5;
  const float* wm = p.w_mod + (size_t)l * DM * 6144 + cb + j;
  float a0 = 0, a1 = 0, a2 = 0, a3 = 0, a4 = 0;
  for (int k = ks * 64; k < ks * 64 + 64; ++k) {
    const float w = wm[(size_t)k * 6144];
    a0 += w * sil[k]; a1 += w * sil[1024 + k]; a2 += w * sil[2048 + k]; a3 += w * sil[3072 + k]; a4 += w * sil[4096 + k];
  }
  red[(ks * 32 + j) * 5 + 0] = a0; red[(ks * 32 + j) * 5 + 1] = a1; red[(ks * 32 + j) * 5 + 2] = a2;
  red[(ks * 32 + j) * 5 + 3] = a3; red[(ks * 32 + j) * 5 + 4] = a4;
  __syncthreads();
  if (tid_() < 160) {
    int b = tid_() >> 5, jj = tid_() & 31;
    float s = p.b_mod[l * 6144 + cb + jj];
    for (int q = 0; q < 16; ++q) s += red[(q * 32 + jj) * 5 + b];
    p.mod[(size_t)(l * 5 + b) * 6144 + cb + jj] = s;
  }
  __syncthreads();
}

DI void misc_job(const Params& p) {
  const int tid = tid_();
  if (tid < 256)
  for (int dirn = 0; dirn < 2; ++dirn) {
    float v[4], mx = -1e30f;
    for (int l = 0; l < 4; ++l) { v[l] = p.hg_lb[(dirn * 4 + l) * 256 + tid]; mx = fmaxf(mx, v[l]); }
    float s = 0; for (int l = 0; l < 4; ++l) { v[l] = expf(v[l] - mx); s += v[l]; }
    float cum = 0, first = 0;
    for (int l = 0; l < 4; ++l) { cum += v[l] / s; if (l == 0) first = cum; p.lb[(dirn * 4 + l) * 256 + tid] = cum - first; }
  }
  for (int e = tid; e < 128 * 16; e += NTHR) {
    int pos = e >> 4, f = e & 15;
    float inv = exp2f(-(float)f * (13.287712379549449f / 16.f));
    float ang = (float)pos * inv, sn, cs;
    my_sincos(ang, &sn, &cs);
    p.ropeS[2 * e] = cs; p.ropeS[2 * e + 1] = sn;
  }
  for (int e = tid; e < 128 * 8; e += NTHR) {
    int pos = e >> 3, f = e & 7;
    float inv = exp2f(-(float)f * (13.287712379549449f / 8.f));
    float ang = (float)pos * inv, sn, cs;
    my_sincos(ang, &sn, &cs);
    p.ropeM[2 * e] = cs; p.ropeM[2 * e + 1] = sn;
  }
}

DI void s5tab_job(float* sm, const Params& p, int jb) {
  float2* s_ap = (float2*)sm;
  float2* s_bb = s_ap + 33 * 64;
  float2* s_c = s_bb + 64 * 16;
  const int tid = tid_();
  if (tid < 64) {
    const int pi = jb * 64 + tid;
    float lr = p.lam_re[pi], li = p.lam_im[pi], dt = expf(p.log_dt[pi]);
    float zr = lr * dt, zi = li * dt;
#pragma unroll 1
    for (int t = 0; t <= 32; ++t) {
      float mag = expf((float)t * zr), ang = (float)t * zi, sn, cs;
      my_sincos(ang, &sn, &cs);
      float2 v = make_float2(mag * cs, mag * sn);
      s_ap[t * 64 + tid] = v;
      p.apow[((size_t)jb * 33 + t) * 128 + tid * 2] = v.x;
      p.apow[((size_t)jb * 33 + t) * 128 + tid * 2 + 1] = v.y;
    }
    float cr, ci;
    if (zr * zr + zi * zi < 0.01f) {
      float pr = 1.f, pi_ = 0.f, tr = 1.f, ti = 0.f;
#pragma unroll
      for (int n = 2; n <= 7; ++n) {
        const float nr = (tr * zr - ti * zi) / (float)n, ni = (tr * zi + ti * zr) / (float)n;
        tr = nr; ti = ni; pr += tr; pi_ += ti;
      }
      cr = dt * pr; ci = dt * pi_;
    } else {
      float sn1, cs1;
      my_sincos(zi, &sn1, &cs1);
      const float ar = expf(zr) * cs1 - 1.f, ai = expf(zr) * sn1;
      const float den = lr * lr + li * li;
      cr = (ar * lr + ai * li) / den; ci = (ai * lr - ar * li) / den;
    }
#pragma unroll 1
    for (int hh = 0; hh < 16; ++hh) {
      float br = p.b_re[(size_t)pi * 16 + hh], bi = p.b_im[(size_t)pi * 16 + hh];
      float2 v = make_float2(cr * br - ci * bi, cr * bi + ci * br);
      s_bb[tid * 16 + hh] = v;
      p.bbar[((size_t)pi * 16 + hh) * 2] = v.x; p.bbar[((size_t)pi * 16 + hh) * 2 + 1] = v.y;
    }
  }
  for (int e = tid; e < 1024; e += NTHR) s_c[e] = make_float2(p.c_re[(size_t)jb * 1024 + e], p.c_im[(size_t)jb * 1024 + e]);
  __syncthreads();
  const int hh = (tid >> 4) & 15, hp = tid & 15, th = tid >> 8;
#pragma unroll 1
  for (int t = th; t < 32; t += 2) {
    float acc = 0;
#pragma unroll 4
    for (int q = 0; q < 64; ++q) {
      float2 c = s_c[hh * 64 + q], a = s_ap[t * 64 + q], b = s_bb[q * 16 + hp];
      float wr = c.x * a.x - c.y * a.y, wi = c.x * a.y + c.y * a.x;
      acc += wr * b.x - wi * b.y;
    }
    p.Ktab[((size_t)jb * 32 + t) * 256 + (tid & 255)] = acc;
  }
  __syncthreads();
}

constexpr int J_MOD = 768;
constexpr int CT_WI = 78 * 4, CT_WO = 32 * 4, CT_WU = 176 * 4, CT_WD = 32 * 11, CT_WG = 8 * 1, CT_WQ = 12 * 1, CT_WKV = 16 * 1;
constexpr int CT_LAYER = CT_WI + CT_WO + CT_WU + CT_WD + CT_WG + CT_WQ + CT_WKV;
constexpr int J_CONV = CT_LAYER * DEPTH;
constexpr int J_S5TAB = DEPTH * 2 * 16;

DI void phase_prep(char* smem, const Params& p) {
  float* sm = (float*)smem;
  float* sil = (float*)(smem + 65536);
  for (int e = tid_(); e < 5 * 1024; e += NTHR) {
    const float c = e < 4096 ? p.c[e] : p.c_ctx[e - 4096];
    sil[e] = c * sigmoidf_(c);
  }
  __syncthreads();
  const int total = J_MOD + J_S5TAB + 1 + J_CONV;
  for (int job = bid_(); job < total; job += gridDim.x) {
    int j = job;
    if (j < J_MOD) { mod_job(sm, sil, p, j); continue; }
    j -= J_MOD;
    if (j < J_S5TAB) { s5tab_job(sm, p, j); continue; }
    j -= J_S5TAB;
    if (j < 1) { misc_job(p); continue; }
    j -= 1;
    const int l = j / CT_LAYER; int q = j - l * CT_LAYER;
    if (q < CT_WI) { int nt = q / 4, kt = q % 4; conv_tile<256>(sm, p.w_in + (size_t)l * DM * NIN, NIN, nullptr, p.Wi + (size_t)l * NINP * DM, DM, nt * 32, kt * 256, 0); continue; }
    q -= CT_WI;
    if (q < CT_WO) { int nt = q / 4, kt = q % 4; conv_tile<256>(sm, p.w_out + (size_t)l * DM * DM, DM, nullptr, p.Wo + (size_t)l * DM * DM, DM, nt * 32, kt * 256, 3); continue; }
    q -= CT_WO;
    if (q < CT_WU) { int nt = q / 4, kt = q % 4; conv_tile<256>(sm, p.w_up + (size_t)l * DM * 2 * FH, 2 * FH, nullptr, p.Wu + (size_t)l * 2 * FH * DM, DM, nt * 32, kt * 256, 2); continue; }
    q -= CT_WU;
    if (q < CT_WD) { int nt = q / 11, kt = q % 11; conv_tile<256>(sm, p.w_down + (size_t)l * FH * DM, DM, nullptr, p.Wd + (size_t)l * DM * FH, FH, nt * 32, kt * 256, 3); continue; }
    q -= CT_WD;
    if (q < CT_WG) { int nt = q, kt = 0; conv_tile<256>(sm, p.w_glu + (size_t)l * 65536, 256, nullptr, p.Wg + (size_t)l * 65536, 256, nt * 32, kt * 256, 3); continue; }
    q -= CT_WG;
    if (q < CT_WQ) { int nt = q, kt = 0; conv_tile<256>(sm, p.w_qb + (size_t)l * 256 * 384, 384, p.q_norm_g + l * 256, p.Wq + (size_t)l * 384 * 256, 256, nt * 32, kt * 256, 1); continue; }
    q -= CT_WQ;
    { int nt = q, kt = 0; conv_tile<128>(sm, p.w_kvb + (size_t)l * 128 * 512, 512, p.kv_norm_g + l * 128, p.Wkv + (size_t)l * 512 * 128, 128, nt * 32, kt * 128, 3); }
  }
}

DI void phase_s5mats(const Params& p) {
  const int TW_ROWS = DEPTH * 16 * 512, W1_ROWS = DEPTH * 16 * 256;
  const size_t n_tw = (size_t)TW_ROWS * 96, n_w1 = (size_t)W1_ROWS * 64;
  for (size_t e = (size_t)bid_() * NTHR + tid_(); e < n_tw + n_w1; e += (size_t)gridDim.x * NTHR) {
    float v[8];
    bf16_t* dst;
    if (e < n_tw) {
      const int row = (int)(e / 96), kg = (int)(e % 96);
      const int lg = row >> 9, n = row & 511, t = n >> 4, hh = n & 15;
      const int l = lg >> 4, g = lg & 15;
      const int k = kg * 8;
      dst = p.TW + (size_t)row * 768 + k;
      if (k < 512) {
        const int s = k >> 4, h0 = k & 15;
        const float* Kf = p.Ktab + ((size_t)((l * 2 + 0) * 16 + g) * 32) * 256;
        const float* Kb = p.Ktab + ((size_t)((l * 2 + 1) * 16 + g) * 32) * 256;
        const int ds = t - s, df = ds >= 0 ? ds : 0, db = ds <= 0 ? -ds : 0;
        const float mf = ds >= 0 ? 1.f : 0.f, mb = ds <= 0 ? 1.f : 0.f;
        const float4 f0 = *(const float4*)(Kf + df * 256 + hh * 16 + h0), f1 = *(const float4*)(Kf + df * 256 + hh * 16 + h0 + 4);
        const float4 b0 = *(const float4*)(Kb + db * 256 + hh * 16 + h0), b1 = *(const float4*)(Kb + db * 256 + hh * 16 + h0 + 4);
        v[0] = mf * f0.x + mb * b0.x; v[1] = mf * f0.y + mb * b0.y; v[2] = mf * f0.z + mb * b0.z; v[3] = mf * f0.w + mb * b0.w;
        v[4] = mf * f1.x + mb * b1.x; v[5] = mf * f1.y + mb * b1.y; v[6] = mf * f1.z + mb * b1.z; v[7] = mf * f1.w + mb * b1.w;
        if (ds == 0) {
          const float dsk = p.s5_d[l * 256 + g * 16 + hh];
#pragma unroll
          for (int j = 0; j < 8; ++j) if (hh == h0 + j) v[j] += dsk;
        }
      } else {
        const int dirn = (k - 512) >> 7, p0 = ((k - 512) & 127) >> 1;
        const int jb = (l * 2 + dirn) * 16 + g;
        const int ex = dirn == 0 ? t + 1 : 32 - t;
#pragma unroll
        for (int j = 0; j < 8; ++j) {
          const int pp = p0 + (j >> 1);
          float cr = p.c_re[((size_t)jb * 16 + hh) * 64 + pp], ci = p.c_im[((size_t)jb * 16 + hh) * 64 + pp];
          float ar = p.apow[((size_t)jb * 33 + ex) * 128 + pp * 2], ai = p.apow[((size_t)jb * 33 + ex) * 128 + pp * 2 + 1];
          v[j] = (j & 1) ? -(cr * ai + ci * ar) : (cr * ar - ci * ai);
        }
      }
    } else {
      const size_t e2 = e - n_tw;
      const int row = (int)(e2 / 64), kg = (int)(e2 % 64);
      const int lg = row >> 8, n = row & 255;
      const int l = lg >> 4, g = lg & 15;
      const int dirn = n >> 7, pp = (n & 127) >> 1, ri = n & 1;
      const int k = kg * 8, s = k >> 4, h0 = k & 15;
      const int jb = (l * 2 + dirn) * 16 + g;
      const int ex = dirn == 0 ? 31 - s : s;
      dst = p.W1 + (size_t)row * 512 + k;
      float ar = p.apow[((size_t)jb * 33 + ex) * 128 + pp * 2], ai = p.apow[((size_t)jb * 33 + ex) * 128 + pp * 2 + 1];
#pragma unroll
      for (int j = 0; j < 8; ++j) {
        float br = p.bbar[(((size_t)jb * 64 + pp) * 16 + h0 + j) * 2], bi = p.bbar[(((size_t)jb * 64 + pp) * 16 + h0 + j) * 2 + 1];
        v[j] = ri ? (ar * bi + ai * br) : (ar * br - ai * bi);
      }
    }
    uint4 o; o.x = pack2(v[0], v[1]); o.y = pack2(v[2], v[3]); o.z = pack2(v[4], v[5]); o.w = pack2(v[6], v[7]);
    *(uint4*)dst = o;
  }
}

DI void phase_norm(const Params& p, int layer, int which, bool first) {
  const int w = tid_() >> 6, l = tid_() & 63;
  const float* g = (which ? p.norm2_g : p.norm1_g) + layer * DM;
  for (int row = bid_() * 8 + w; row < R / 2; row += gridDim.x * 8) {
    float4 v[2][4]; float ss[2];
#pragma unroll
    for (int u = 0; u < 2; ++u) {
      const float* xr = xsrc_row(p, first, row + u * (R / 2));
      ss[u] = 0;
#pragma unroll
      for (int i = 0; i < 4; ++i) { v[u][i] = *(const float4*)(xr + i * 256 + l * 4); ss[u] += v[u][i].x * v[u][i].x + v[u][i].y * v[u][i].y + v[u][i].z * v[u][i].z + v[u][i].w * v[u][i].w; }
    }
#pragma unroll
    for (int u = 0; u < 2; ++u) {
      const int rw = row + u * (R / 2);
      const int b = rw / TT, t = rw - b * TT;
      const float* md = p.mod + (size_t)(layer * 5 + (t < CTXL ? 4 : b)) * 6144 + which * 3072;
      const float rs = rsqrtf(wave_sum(ss[u]) * (1.f / DM) + EPSN);
#pragma unroll
      for (int i = 0; i < 4; ++i) {
        const int c = i * 256 + l * 4;
        float4 gg = *(const float4*)(g + c), sh = *(const float4*)(md + c), sc = *(const float4*)(md + 1024 + c);
        float o0 = v[u][i].x * rs * gg.x * (1.f + sc.x) + sh.x, o1 = v[u][i].y * rs * gg.y * (1.f + sc.y) + sh.y;
        float o2 = v[u][i].z * rs * gg.z * (1.f + sc.z) + sh.z, o3 = v[u][i].w * rs * gg.w * (1.f + sc.w) + sh.w;
        uint2 o; o.x = pack2(o0, o1); o.y = pack2(o2, o3);
        *(uint2*)(p.Hn + (size_t)rw * DM + c) = o;
      }
    }
  }
}

DI void phase_final_norm(const Params& p) {
  const int w = tid_() >> 6, l = tid_() & 63;
  constexpr int NR = NBATCH * SEQ;
  for (int row = bid_() * 8 + w; row < NR / 2; row += gridDim.x * 8) {
    float4 v[2][4]; float ss[2];
#pragma unroll
    for (int u = 0; u < 2; ++u) {
      const float* xr = p.out + (size_t)(row + u * (NR / 2)) * DM;
      ss[u] = 0;
#pragma unroll
      for (int i = 0; i < 4; ++i) { v[u][i] = *(const float4*)(xr + i * 256 + l * 4); ss[u] += v[u][i].x * v[u][i].x + v[u][i].y * v[u][i].y + v[u][i].z * v[u][i].z + v[u][i].w * v[u][i].w; }
    }
#pragma unroll
    for (int u = 0; u < 2; ++u) {
      float* xr = p.out + (size_t)(row + u * (NR / 2)) * DM;
      const float rs = rsqrtf(wave_sum(ss[u]) * (1.f / DM) + EPSN);
#pragma unroll
      for (int i = 0; i < 4; ++i) {
        const int c = i * 256 + l * 4;
        float4 gg = *(const float4*)(p.final_g + c);
        *(float4*)(xr + c) = make_float4(v[u][i].x * rs * gg.x, v[u][i].y * rs * gg.y, v[u][i].z * rs * gg.z, v[u][i].w * rs * gg.w);
      }
    }
  }
}

template <int MI = 4, class AL, class EP>
DI void gemm_tile(char* smem, const AL& al, const bf16_t* __restrict__ B, int ldb, int N, const EP& ep, int m0, int n0, int K) {
  bf16_t* sA = (bf16_t*)smem;
  bf16_t* sB = sA + 2 * 256 * 72;
  const int tid = tid_(), w = tid >> 6, l = tid & 63, r = l & 31, h = l >> 5;
  const int wm = w >> 2, wn = w & 3;
  const int lrow = tid >> 3, lk = (tid & 7) * 8;
  f32x16 acc[MI][2];
#pragma unroll
  for (int a = 0; a < MI; ++a)
#pragma unroll
    for (int b = 0; b < 2; ++b)
#pragma unroll
      for (int i = 0; i < 16; ++i) acc[a][b][i] = 0.f;
  const bf16_t* Bp0 = B + (size_t)min(n0 + lrow, N - 1) * ldb + lk;
  const bf16_t* Bp1 = B + (size_t)min(n0 + lrow + 64, N - 1) * ldb + lk;
  const bf16_t* Bp2 = B + (size_t)min(n0 + lrow + 128, N - 1) * ldb + lk;
  const bf16_t* Bp3 = B + (size_t)min(n0 + lrow + 192, N - 1) * ldb + lk;
  uint4 xa0, xa1, xa2, xa3, xb0, xb1, xb2, xb3;
  xa1 = xa2 = xa3 = make_uint4(0, 0, 0, 0);
#define GLOADX(kk) \
  xa0 = al(m0 + lrow, (kk) + lk); if (MI > 1) xa1 = al(m0 + lrow + 64, (kk) + lk); if (MI > 2) { xa2 = al(m0 + lrow + 128, (kk) + lk); xa3 = al(m0 + lrow + 192, (kk) + lk); } \
  xb0 = *(const uint4*)(Bp0 + (kk)); xb1 = *(const uint4*)(Bp1 + (kk)); xb2 = *(const uint4*)(Bp2 + (kk)); xb3 = *(const uint4*)(Bp3 + (kk));
#define SSTOREX(bb) \
  *(uint4*)(sA + (bb) * 18432 + (lrow) * 72 + lk) = xa0; if (MI > 1) *(uint4*)(sA + (bb) * 18432 + (lrow + 64) * 72 + lk) = xa1; \
  if (MI > 2) { *(uint4*)(sA + (bb) * 18432 + (lrow + 128) * 72 + lk) = xa2; *(uint4*)(sA + (bb) * 18432 + (lrow + 192) * 72 + lk) = xa3; } \
  *(uint4*)(sB + (bb) * 18432 + (lrow) * 72 + lk) = xb0; *(uint4*)(sB + (bb) * 18432 + (lrow + 64) * 72 + lk) = xb1; \
  *(uint4*)(sB + (bb) * 18432 + (lrow + 128) * 72 + lk) = xb2; *(uint4*)(sB + (bb) * 18432 + (lrow + 192) * 72 + lk) = xb3;
  const int nk = K >> 6;
  GLOADX(0)
  __syncthreads();
  SSTOREX(0)
  GLOADX(min(1, nk - 1) * 64)
  for (int kt = 0; kt < nk; ++kt) {
    const int buf = kt & 1;
    __syncthreads();
    SSTOREX(buf ^ 1)
    __builtin_amdgcn_sched_barrier(0);
    GLOADX(min(kt + 2, nk - 1) * 64)
    __builtin_amdgcn_sched_barrier(0);
    const bf16_t* cA = sA + buf * 18432 + (wm * 32 * MI + r) * 72 + 8 * h;
    const bf16_t* cB = sB + buf * 18432 + (wn * 64 + r) * 72 + 8 * h;
#pragma unroll
    for (int ks = 0; ks < 4; ++ks) {
      bf16x8 b0 = *(const bf16x8*)(cB + ks * 16), b1 = *(const bf16x8*)(cB + 32 * 72 + ks * 16);
#pragma unroll
      for (int a = 0; a < MI; ++a) {
        bf16x8 af = *(const bf16x8*)(cA + a * 32 * 72 + ks * 16);
        acc[a][0] = MFMA32(b0, af, acc[a][0]);
        acc[a][1] = MFMA32(b1, af, acc[a][1]);
      }
    }
  }
#undef GLOADX
#undef SSTOREX
  const int row0 = m0 + wm * 32 * MI + r, cb0 = n0 + wn * 64 + 4 * h;
  if constexpr (std::is_invocable_v<EP, int, int, int, const f32x16&, const f32x16&>) {
#pragma unroll
    for (int a = 0; a < MI; ++a) ep(row0 + 32 * a, n0 + wn * 64, h, acc[a][0], acc[a][1]);
  } else {
#pragma unroll
    for (int a = 0; a < MI; ++a)
#pragma unroll
      for (int g = 0; g < 4; ++g) {
        ep(row0 + 32 * a, cb0 + 8 * g, acc[a][0][4 * g], acc[a][0][4 * g + 1], acc[a][0][4 * g + 2], acc[a][0][4 * g + 3]);
        ep(row0 + 32 * a, cb0 + 32 + 8 * g, acc[a][1][4 * g], acc[a][1][4 * g + 1], acc[a][1][4 * g + 2], acc[a][1][4 * g + 3]);
      }
  }
}


template <int MI = 4, class EP>
DI void gemm_tile_dma(char* smem, const bf16_t* __restrict__ A, int lda, const bf16_t* __restrict__ B, int ldb, int N,
                      const EP& ep, int m0, int n0, int K) {
  constexpr int STAGE = 65536;
  constexpr int MT = 2 * MI;
  const int tid = tid_(), w = tid >> 6, l = tid & 63, r16 = l & 15, q4 = l >> 4;
  const int wm = w >> 2, wn = w & 3;
  f32x4 acc[MT][4];
#pragma unroll
  for (int a = 0; a < MT; ++a)
#pragma unroll
    for (int b = 0; b < 4; ++b) { acc[a][b][0] = 0.f; acc[a][b][1] = 0.f; acc[a][b][2] = 0.f; acc[a][b][3] = 0.f; }
  const int srow = tid >> 3, slog = (tid & 7) ^ ((tid >> 4) & 7);
  const bf16_t* Ag = A + (size_t)(m0 + srow) * lda + slog * 8;
  const bf16_t* Bg0 = B + (size_t)min(n0 + srow, N - 1) * ldb + slog * 8;
  const bf16_t* Bg1 = B + (size_t)min(n0 + srow + 64, N - 1) * ldb + slog * 8;
  const bf16_t* Bg2 = B + (size_t)min(n0 + srow + 128, N - 1) * ldb + slog * 8;
  const bf16_t* Bg3 = B + (size_t)min(n0 + srow + 192, N - 1) * ldb + slog * 8;
  char* wbase = smem + w * 1024;
#define DMA16(g, lds) __builtin_amdgcn_global_load_lds((const unsigned*)(g), (unsigned*)(lds), 16, 0, 0)
#define STAGE_TILE(bb, kk) { char* sb_ = wbase + (bb) * STAGE; \
    DMA16(Ag + (kk), sb_); \
    if (MI > 1) DMA16(Ag + (size_t)64 * lda + (kk), sb_ + 8192); \
    if (MI > 2) { DMA16(Ag + (size_t)128 * lda + (kk), sb_ + 16384); DMA16(Ag + (size_t)192 * lda + (kk), sb_ + 24576); } \
    DMA16(Bg0 + (kk), sb_ + 32768); DMA16(Bg1 + (kk), sb_ + 32768 + 8192); \
    DMA16(Bg2 + (kk), sb_ + 32768 + 16384); DMA16(Bg3 + (kk), sb_ + 32768 + 24576); }
  const int nk = K >> 6;
  __syncthreads();
  STAGE_TILE(0, 0)
  asm volatile("s_waitcnt vmcnt(0)" ::: "memory");
  __syncthreads();
  const int swz = r16 >> 1;
  for (int kt = 0; kt < nk; ++kt) {
    const int buf = kt & 1;
    if (kt + 1 < nk) STAGE_TILE(buf ^ 1, (kt + 1) * 64)
    const char* cA = smem + buf * STAGE + (wm * 32 * MI + r16) * 128;
    const char* cB = smem + buf * STAGE + 32768 + (wn * 64 + r16) * 128;
#pragma unroll
    for (int k2 = 0; k2 < 2; ++k2) {
      const int po = ((4 * k2 + q4) ^ swz) * 16;
      bf16x8 bf[4];
#pragma unroll
      for (int nt = 0; nt < 4; ++nt) bf[nt] = *(const bf16x8*)(cB + nt * 16 * 128 + po);
      bf16x8 afc = *(const bf16x8*)(cA + po);
#pragma unroll
      for (int a = 0; a < MT; ++a) {
        bf16x8 afn = afc;
        if (a + 1 < MT) afn = *(const bf16x8*)(cA + (a + 1) * 16 * 128 + po);
        __builtin_amdgcn_sched_barrier(0);
#pragma unroll
        for (int nt = 0; nt < 4; ++nt) acc[a][nt] = MFMA16(bf[nt], afc, acc[a][nt]);
        __builtin_amdgcn_sched_barrier(0);
        afc = afn;
      }
    }
    asm volatile("s_waitcnt vmcnt(0)" ::: "memory");
    __syncthreads();
  }
#undef DMA16
#undef STAGE_TILE
  const int row0 = m0 + wm * 32 * MI + r16, cbw = n0 + wn * 64;
  if constexpr (std::is_invocable_v<EP, int, int, int, const f32x4&, const f32x4&, const f32x4&, const f32x4&>) {
#pragma unroll
    for (int a = 0; a < MT; ++a) ep(row0 + 16 * a, cbw, q4, acc[a][0], acc[a][1], acc[a][2], acc[a][3]);
  } else {
#pragma unroll
    for (int a = 0; a < MT; ++a)
#pragma unroll
      for (int nt = 0; nt < 4; ++nt)
        ep(row0 + 16 * a, cbw + 16 * nt + 4 * q4, acc[a][nt][0], acc[a][nt][1], acc[a][nt][2], acc[a][nt][3]);
  }
}

DI void row_rms(float* rs, const bf16_t* __restrict__ A, int lda, int m0, int K) {
  const int row = tid_() >> 1, hf = tid_() & 1;
  const bf16_t* a = A + (size_t)(m0 + row) * lda + hf * (K >> 1);
  float ss = 0;
  for (int k = 0; k < (K >> 1); k += 8) {
    uint4 v = *(const uint4*)(a + k);
    float lo, hi;
    lo = __uint_as_float(v.x << 16); hi = __uint_as_float(v.x & 0xffff0000u); ss += lo * lo + hi * hi;
    lo = __uint_as_float(v.y << 16); hi = __uint_as_float(v.y & 0xffff0000u); ss += lo * lo + hi * hi;
    lo = __uint_as_float(v.z << 16); hi = __uint_as_float(v.z & 0xffff0000u); ss += lo * lo + hi * hi;
    lo = __uint_as_float(v.w << 16); hi = __uint_as_float(v.w & 0xffff0000u); ss += lo * lo + hi * hi;
  }
  ss += __shfl_xor(ss, 1, 64);
  __syncthreads();
  if (hf == 0) rs[row] = rsqrtf(ss / (float)K + EPSN);
  __syncthreads();
}

template <int TMI, class F>
DI void for_tiles_xcd(int MT, int NT, const F& f) {
  const int total = MT * NT, G = gridDim.x, nslots = G >> 3;
  const int b = bid_(), x = b & 7, slot = b >> 3;
  const int total_full = (total / G) * G;
  const int full = (MT >> 3) * 8 * NT, gsz = MT - (MT >> 3) * 8;
  auto decode = [&](int L, int& mt, int& nt) {
    if (L < full) { const int mg = L / (8 * NT), rem = L - mg * 8 * NT; mt = mg * 8 + (rem & 7); nt = rem >> 3; }
    else { const int rem = L - full; nt = rem / gsz; mt = (MT >> 3) * 8 + (rem - nt * gsz); }
  };
  if (slot < nslots)
    for (int c = x; c * 32 < total_full; c += 8)
      for (int kk = slot; kk < 32; kk += nslots) {
        const int L = c * 32 + kk;
        if (L >= total_full) break;
        int mt, nt; decode(L, mt, nt);
        f(mt * 256, nt, std::integral_constant<int, 4>{});
      }
  constexpr int PIECES = 4 / TMI;
  const int npieces = (total - total_full) * PIECES;
  for (int q = b; q < npieces; q += G) {
    int mt, nt; decode(total_full + q / PIECES, mt, nt);
    f(mt * 256 + (q % PIECES) * 64 * TMI, nt, std::integral_constant<int, TMI>{});
  }
}

DI void phase_win(char* smem, const Params& p, int layer) {
  const bf16_t* Hn = p.Hn;
  auto al = [=](int row, int k) -> uint4 { return *(const uint4*)(Hn + (size_t)row * DM + k); };
  const float qscale = 0.125f * LOG2E;
  auto ep = [&](int row, int cbw, int q4, const f32x4& c0, const f32x4& c1, const f32x4& c2, const f32x4& c3) {
    if (cbw > 2432) return;
    const int b = row / TT, t = row - b * TT;
    const bool lat = t >= CTXL;
    const int pos = t - CTXL;
    float v[16] = {c0[0], c0[1], c0[2], c0[3], c1[0], c1[1], c1[2], c1[3], c2[0], c2[1], c2[2], c2[3], c3[0], c3[1], c3[2], c3[3]};
    if (cbw >= 640 && cbw < 768) {
      bf16_t* vp = p.VsT + ((size_t)(b * 2 + ((cbw - 640) >> 6)) * 64 + q4 * 16) * TT + t;
#pragma unroll
      for (int i = 0; i < 16; ++i) vp[(size_t)i * TT] = f2bf(v[i]);
      return;
    }
    const bool r16 = cbw >= 256 && cbw < 640, rkr = cbw == 2432;
    if (rkr && q4 >= 2) return;
    if (lat && (r16 || rkr)) {
      const int a = r16 ? (q4 >> 1) : q4;
      const int pa = a ? (pos & 63) : (pos >> 6);
      const float* tab = r16 ? p.ropeS + 2 * (pa * 16 + (q4 & 1) * 8) : p.ropeM + 2 * (pa * 8);
#pragma unroll
      for (int k = 0; k < 4; ++k) {
        const float4 cs = *(const float4*)(tab + 4 * k);
        const float x0 = v[4 * k], x1 = v[4 * k + 1], x2 = v[4 * k + 2], x3 = v[4 * k + 3];
        v[4 * k] = x0 * cs.x - x1 * cs.y; v[4 * k + 1] = x1 * cs.x + x0 * cs.y;
        v[4 * k + 2] = x2 * cs.z - x3 * cs.w; v[4 * k + 3] = x3 * cs.z + x2 * cs.w;
      }
    }
    if (cbw >= 256 && cbw < 512) {
#pragma unroll
      for (int i = 0; i < 16; ++i) v[i] *= qscale;
    }
    const uint4 lo = make_uint4(pack2(v[0], v[1]), pack2(v[2], v[3]), pack2(v[4], v[5]), pack2(v[6], v[7]));
    const uint4 hi = make_uint4(pack2(v[8], v[9]), pack2(v[10], v[11]), pack2(v[12], v[13]), pack2(v[14], v[15]));
    if (rkr) {
#pragma unroll
      for (int hd = 0; hd < 4; ++hd) {
        bf16_t* d = p.Km + ((size_t)(b * 4 + hd) * TT + t) * 96 + 64 + q4 * 16;
        *(uint4*)d = lo; *(uint4*)(d + 8) = hi;
      }
      return;
    }
    bf16_t* d;
    if (cbw < 256) d = p.Pu + (size_t)row * 256 + cbw;
    else if (cbw < 512) d = p.Qs + ((size_t)(b * 4 + ((cbw - 256) >> 6)) * TT + t) * 64;
    else if (cbw < 640) d = p.Ks + ((size_t)(b * 2 + ((cbw - 512) >> 6)) * TT + t) * 64;
    else if (cbw < 2048) d = p.PH + (size_t)row * 1280 + (cbw - 768);
    else d = p.Pm + (size_t)row * 384 + (cbw - 2048);
    d += q4 * 16;
    *(uint4*)d = lo; *(uint4*)(d + 8) = hi;
  };
  const bf16_t* W = p.Wi + (size_t)layer * NINP * DM;
  for_tiles_xcd<1>(R / 256, 10, [&](int m0, int nt, auto mi) { gemm_tile_dma<decltype(mi)::value>(smem, Hn, DM, W, DM, NINP, ep, m0, nt * 256, DM); });
}

DI int hg_tok(int dirn, int j) { return dirn == 0 ? j : (j < CTXL ? CTXL - 1 - j : TT + CTXL - 1 - j); }

template <bool FULL>
DI void hg_item(char* smem, const Params& p, int layer, int item) {
  bf16_t* qd = (bf16_t*)(smem + (tid_() >> 8) * 36864);
  bf16_t* ki = qd + 32 * 72;
  bf16_t* keT = ki + 32 * 72;
  bf16_t* vT = keT + 64 * 40;
  bf16_t* att = vT + 64 * 40;
  bf16_t* ST = att + 32 * 40;
  float* tot = (float*)(ST + 64 * 72);
  float* decs = tot + 256;
  const int tid = tid_() & 255, half = tid_() >> 8, w = tid >> 6, l = tid & 63, r16 = l & 15, q4 = l >> 4;
  item = item * 2 + half;
  const int sc = item % NSC, chain = item / NSC;
  const int dirn = chain & 1, head = (chain >> 1) & 3, b = chain >> 3;
  const int d = l, tq = w;
  __syncthreads();
  const float lbv = p.lb[(dirn * 4 + layer) * 256 + head * 64 + d];
  bf16_t* Odir = dirn ? p.OB : p.OF;
  float* Est = p.Eh + (size_t)item * 4096;
  f32x4 sacc[4];
#pragma unroll
  for (int di = 0; di < 4; ++di)
#pragma unroll
    for (int jj = 0; jj < 4; ++jj) {
      if (FULL) {
        const int v = w * 16 + q4 * 4 + jj, dd = di * 16 + r16;
        const float s0 = Est[v * 64 + dd];
        sacc[di][jj] = s0;
        ST[v * 72 + dd] = f2bf(s0);
      } else sacc[di][jj] = 0.f;
    }
  float dprod = 1.f;
  __syncthreads();
  bf16_t pz[4][8], pq[4][8], pv[4][8];
#pragma unroll
  for (int sub = 0; sub < 4; ++sub)
#pragma unroll
    for (int ii = 0; ii < 8; ++ii) {
      const int t = hg_tok(dirn, sc * 128 + sub * 32 + tq * 8 + ii);
      const bf16_t* ph = p.PH + ((size_t)b * TT + t) * 1280 + head * 64 + d;
      pz[sub][ii] = ph[dirn ? 512 : 256];
      if (FULL) pq[sub][ii] = ph[0];
      pv[sub][ii] = ph[768];
    }
#pragma unroll
  for (int sub = 0; sub < 4; ++sub) {
    const int j0 = sc * 128 + sub * 32;
    float cum[8], kk[8], qv[8], vv[8];
    float csum = 0;
#pragma unroll
    for (int ii = 0; ii < 8; ++ii) {
      const float z = bf2f(pz[sub][ii]);
      qv[ii] = FULL ? bf2f(pq[sub][ii]) : 0.f; vv[ii] = bf2f(pv[sub][ii]);
      const float sg = __builtin_amdgcn_rcpf(1.f + __expf(-z)), sgn = __builtin_amdgcn_rcpf(1.f + __expf(z));
      const float f = lbv + (1.f - lbv) * sg;
      kk[ii] = (1.f - lbv) * sgn;
      csum += __logf(f);
      cum[ii] = csum;
    }
    tot[tq * 64 + d] = csum;
    __syncthreads();
    float off = 0, last = 0;
#pragma unroll
    for (int q = 0; q < 4; ++q) { const float tv = tot[q * 64 + d]; last += tv; if (q < tq) off += tv; }
#pragma unroll
    for (int ii = 0; ii < 8; ++ii) {
      const int i = tq * 8 + ii;
      const float cu = off + cum[ii];
      if (FULL) { qd[i * 72 + d] = f2bf(qv[ii] * __expf(cu)); ki[i * 72 + d] = f2bf(kk[ii] * __expf(-cu)); }
      keT[d * 40 + i] = f2bf(kk[ii] * __expf(last - cu));
      vT[d * 40 + i] = f2bf(vv[ii]);
    }
    const float dl = __expf(last);
    if (tq == 0) { decs[d] = dl; dprod *= dl; }
    __syncthreads();
    if (FULL) {
      const int ti = w >> 1, si = w & 1;
      f32x4 acc = {0.f, 0.f, 0.f, 0.f};
#pragma unroll
      for (int ks = 0; ks < 2; ++ks) {
        bf16x8 a = *(const bf16x8*)(qd + (ti * 16 + r16) * 72 + ks * 32 + q4 * 8);
        bf16x8 bb = *(const bf16x8*)(ki + (si * 16 + r16) * 72 + ks * 32 + q4 * 8);
        acc = MFMA16(a, bb, acc);
      }
#pragma unroll
      for (int jj = 0; jj < 4; ++jj) {
        const int t = ti * 16 + q4 * 4 + jj, s = si * 16 + r16;
        att[t * 40 + s] = f2bf(s <= t ? acc[jj] : 0.f);
      }
      __syncthreads();
#pragma unroll
      for (int ti2 = 0; ti2 < 2; ++ti2) {
        f32x4 oacc = {0.f, 0.f, 0.f, 0.f};
        {
          bf16x8 a = *(const bf16x8*)(att + (ti2 * 16 + r16) * 40 + q4 * 8);
          bf16x8 bb = *(const bf16x8*)(vT + (w * 16 + r16) * 40 + q4 * 8);
          oacc = MFMA16(a, bb, oacc);
        }
#pragma unroll
        for (int ks = 0; ks < 2; ++ks) {
          bf16x8 a = *(const bf16x8*)(qd + (ti2 * 16 + r16) * 72 + ks * 32 + q4 * 8);
          bf16x8 bb = *(const bf16x8*)(ST + (w * 16 + r16) * 72 + ks * 32 + q4 * 8);
          oacc = MFMA16(a, bb, oacc);
        }
#pragma unroll
        for (int jj = 0; jj < 4; ++jj) {
          const int i = ti2 * 16 + q4 * 4 + jj;
          const int t = hg_tok(dirn, j0 + i);
          Odir[((size_t)b * TT + t) * 256 + head * 64 + w * 16 + r16] = f2bf(oacc[jj]);
        }
      }
    }
#pragma unroll
    for (int di = 0; di < 4; ++di) {
      bf16x8 a = *(const bf16x8*)(vT + (w * 16 + r16) * 40 + q4 * 8);
      bf16x8 bb = *(const bf16x8*)(keT + (di * 16 + r16) * 40 + q4 * 8);
      const float dc = decs[di * 16 + r16];
      f32x4 sv = sacc[di];
      sv[0] *= dc; sv[1] *= dc; sv[2] *= dc; sv[3] *= dc;
      sacc[di] = MFMA16(a, bb, sv);
    }
    if (FULL) {
      __syncthreads();
#pragma unroll
      for (int di = 0; di < 4; ++di)
#pragma unroll
        for (int jj = 0; jj < 4; ++jj) ST[(w * 16 + q4 * 4 + jj) * 72 + di * 16 + r16] = f2bf(sacc[di][jj]);
    }
  }
  if (!FULL) {
#pragma unroll
    for (int di = 0; di < 4; ++di)
#pragma unroll
      for (int jj = 0; jj < 4; ++jj) Est[(w * 16 + q4 * 4 + jj) * 64 + di * 16 + r16] = sacc[di][jj];
    if (tq == 0) p.dech[(size_t)item * 64 + d] = dprod;
  }
  __syncthreads();
}

DI void phase_B(char* smem, const Params& p, int layer) {
  float* rs = (float*)(smem + 147456);
  const int J_E = 16 * 5, J_Q = 132 * 2, J_KV = 132 * 2, J_HG2 = NBATCH * 4 * 2 * NSC / 2;
  const float mscale = 0.10206207261596575f * LOG2E;
  const int G = gridDim.x;
  for (int j = bid_(); j < J_HG2; j += G) hg_item<false>(smem, p, layer, j);
  for (int j = (bid_() + G - (J_HG2 % G)) % G; j < J_E; j += G) {
    const int g = j / 5, mt = j % 5;
    const bf16_t* Pu = p.Pu;
    auto al = [=](int row, int k) -> uint4 {
      row = min(row, NCHR - 1);
      return *(const uint4*)(Pu + ((size_t)row * 32 + (k >> 4)) * 256 + g * 16 + (k & 15));
    };
    float* Es5 = p.Es5;
    auto ep = [=](int row, int col, float v0, float v1, float v2, float v3) { if (row < NCHR) *(float4*)(Es5 + ((size_t)row * 16 + g) * 256 + col) = make_float4(v0, v1, v2, v3); };
    gemm_tile(smem, al, p.W1 + (size_t)(layer * 16 + g) * 256 * 512, 512, 256, ep, mt * 256, 0, 512);
  }
  for (int j = (bid_() + G - ((J_HG2 + J_E) % G)) % G; j < J_Q; j += G) {
    const int mt = j >> 1, nt = j & 1;
    row_rms(rs, p.Pm, 384, mt * 256, 256);
    const bf16_t* Pm = p.Pm;
    auto al = [=](int row, int k) -> uint4 { return *(const uint4*)(Pm + (size_t)row * 384 + k); };
    const float* ropeM = p.ropeM; bf16_t* Qm = p.Qm;
    auto ep = [=](int row, int col, float v0, float v1, float v2, float v3) {
      if (col >= 384) return;
      const int b = row / TT, t = row - b * TT;
      const int hd = col / 96, dd = col - hd * 96;
      const float rr = rs[row - mt * 256] * mscale;
      v0 *= rr; v1 *= rr; v2 *= rr; v3 *= rr;
      if (dd >= 64 && t >= CTXL) {
        const int e = dd - 64, pos = t - CTXL;
        const int a = e >> 4, f = (e & 15) >> 1;
        const int pa = a ? (pos & 63) : (pos >> 6);
        const float4 cs = *(const float4*)(ropeM + 2 * (pa * 8 + f));
        const float o0 = v0 * cs.x - v1 * cs.y, o1 = v1 * cs.x + v0 * cs.y;
        const float o2 = v2 * cs.z - v3 * cs.w, o3 = v3 * cs.z + v2 * cs.w;
        v0 = o0; v1 = o1; v2 = o2; v3 = o3;
      }
      *(uint2*)(Qm + ((size_t)(b * 4 + hd) * TT + t) * 96 + dd) = make_uint2(pack2(v0, v1), pack2(v2, v3));
    };
    gemm_tile_dma<4>(smem, p.Pm, 384, p.Wq + (size_t)layer * 384 * 256, 256, 384, ep, mt * 256, nt * 256, 256);
  }
  for (int j = (bid_() + G - ((J_HG2 + J_E + J_Q) % G)) % G; j < J_KV; j += G) {
    const int mt = j >> 1, nt = j & 1;
    row_rms(rs, p.Pm + 256, 384, mt * 256, 128);
    const bf16_t* Pm = p.Pm + 256;
    auto al = [=](int row, int k) -> uint4 { return *(const uint4*)(Pm + (size_t)row * 384 + k); };
    bf16_t* Km = p.Km; bf16_t* VmT = p.VmT;
    auto ep = [=](int row, int col, float v0, float v1, float v2, float v3) {
      const int b = row / TT, t = row - b * TT;
      const int hd = col >> 7, jj = col & 127;
      const float rr = rs[row - mt * 256];
      v0 *= rr; v1 *= rr; v2 *= rr; v3 *= rr;
      if (jj < 64) *(uint2*)(Km + ((size_t)(b * 4 + hd) * TT + t) * 96 + jj) = make_uint2(pack2(v0, v1), pack2(v2, v3));
      else {
        bf16_t* vp = VmT + ((size_t)(b * 4 + hd) * 64 + (jj - 64)) * TT + t;
        vp[0] = f2bf(v0); vp[TT] = f2bf(v1); vp[2 * TT] = f2bf(v2); vp[3 * TT] = f2bf(v3);
      }
    };
    gemm_tile_dma<4>(smem, p.Pm + 256, 384, p.Wkv + (size_t)layer * 512 * 128, 128, 512, ep, mt * 256, nt * 256, 128);
  }
}

template <int DQK, bool WINDOW>
DI void attn_item(char* smem, const bf16_t* __restrict__ Q, const bf16_t* __restrict__ K, const bf16_t* __restrict__ VT,
                  int qh, int kvh, int b, int q0, bool has_sink, float sink_l2, bf16_t* __restrict__ Y, int ycol) {
  constexpr int KS = DQK / 16, KSTR = DQK + 8, VSTR = 72, KV8 = DQK / 8;
  bf16_t* sK = (bf16_t*)smem;
  bf16_t* sV = sK + 64 * KSTR;
  const int tid = tid_(), w = tid >> 6, l = tid & 63, r = l & 31, h = l >> 5;
  bf16x8 qf[KS];
  {
    const bf16_t* qp = Q + ((size_t)qh * TT + q0 + w * 32 + r) * DQK + 8 * h;
#pragma unroll
    for (int ks = 0; ks < KS; ++ks) qf[ks] = *(const bf16x8*)(qp + ks * 16);
  }
  f32x16 o0, o1;
#pragma unroll
  for (int i = 0; i < 16; ++i) { o0[i] = 0; o1[i] = 0; }
  float m = 0.f, lsum = 0.f;
  int lo, hi;
  if (q0 < CTXL) { lo = CTXL; hi = CTXL; }
  else if (WINDOW) { lo = max(CTXL, q0 - 128); hi = min(TT, q0 + 256 + 128); }
  else { lo = CTXL; hi = TT; }
  const int ntiles = 4 + ((hi - lo) >> 6);
  const bf16_t* Kb = K + (size_t)kvh * TT * DQK;
  const bf16_t* Vb = VT + (size_t)kvh * 64 * TT;
  const int qpos = q0 + w * 32 + r;
  constexpr bool K2 = (64 * KV8) > NTHR;
  constexpr int BUFE = 64 * KSTR + 64 * VSTR;
  uint4 kr0, kr1, vr0;
  kr1 = make_uint4(0, 0, 0, 0);
  const int kidx1 = K2 ? min(tid + NTHR, 64 * KV8 - 1) : 0;
  const int krow0 = tid / KV8, kcc0 = tid - krow0 * KV8, krow1 = kidx1 / KV8, kcc1 = kidx1 - krow1 * KV8;
  const int vrow0 = tid >> 3, vcc0 = tid & 7;
#define TILE_K0(i) ((i) < 4 ? (i) * 64 : lo + ((i) - 4) * 64)
#define ALOAD(i) { const int kk0 = TILE_K0(i); \
    kr0 = *(const uint4*)(Kb + (size_t)(kk0 + krow0) * DQK + kcc0 * 8); \
    if (K2) kr1 = *(const uint4*)(Kb + (size_t)(kk0 + krow1) * DQK + kcc1 * 8); \
    vr0 = *(const uint4*)(Vb + (size_t)vrow0 * TT + kk0 + vcc0 * 8); }
#define ASTORE(bb) { bf16_t* dK = (bf16_t*)smem + (bb) * BUFE; bf16_t* dV = dK + 64 * KSTR; \
    *(uint4*)(dK + krow0 * KSTR + kcc0 * 8) = kr0; \
    if (K2) *(uint4*)(dK + krow1 * KSTR + kcc1 * 8) = kr1; \
    *(uint4*)(dV + vrow0 * VSTR + vcc0 * 8) = vr0; }
  ALOAD(0)
  __syncthreads();
  ASTORE(0)
  ALOAD(min(1, ntiles - 1))
  for (int it = 0; it < ntiles; ++it) {
    const int k0 = TILE_K0(it);
    __syncthreads();
    ASTORE((it + 1) & 1)
    __builtin_amdgcn_sched_barrier(0);
    ALOAD(min(it + 2, ntiles - 1))
    __builtin_amdgcn_sched_barrier(0);
    sK = (bf16_t*)smem + (it & 1) * BUFE;
    sV = sK + 64 * KSTR;
    f32x16 s0, s1;
    const float ninit = -m;
#pragma unroll
    for (int i = 0; i < 16; ++i) { s0[i] = ninit; s1[i] = ninit; }
#pragma unroll
    for (int ks = 0; ks < KS; ++ks) {
      bf16x8 a0 = *(const bf16x8*)(sK + r * KSTR + ks * 16 + 8 * h);
      bf16x8 a1 = *(const bf16x8*)(sK + (32 + r) * KSTR + ks * 16 + 8 * h);
      s0 = MFMA32(a0, qf[ks], s0);
      s1 = MFMA32(a1, qf[ks], s1);
    }
    if (WINDOW && k0 >= CTXL) {
#pragma unroll
      for (int i = 0; i < 16; ++i) {
        const int kp = k0 + crow(i, h);
        if (abs(qpos - kp) > 128) s0[i] = -1e30f;
        if (abs(qpos - kp - 32) > 128) s1[i] = -1e30f;
      }
    }
    int mxb = max(__float_as_int(s0[0]), __float_as_int(s1[0]));
#pragma unroll
    for (int i = 1; i < 16; ++i) mxb = max(mxb, max(__float_as_int(s0[i]), __float_as_int(s1[i])));
    if (__any((it == 0) || (mxb > 0x41000000))) {
      float mx = -1e30f;
#pragma unroll
      for (int i = 0; i < 16; ++i) mx = fmaxf(mx, fmaxf(s0[i], s1[i]));
      mx = fmaxf(mx, __shfl_xor(mx, 32, 64));
      const float delta = (it == 0) ? mx : fmaxf(mx, 0.f);
      const float alpha = (it == 0) ? 1.f : __builtin_amdgcn_exp2f(-delta);
      m += delta;
      lsum *= alpha;
#pragma unroll
      for (int i = 0; i < 16; ++i) { o0[i] *= alpha; o1[i] *= alpha; s0[i] -= delta; s1[i] -= delta; }
    }
    float rsum = 0;
#pragma unroll
    for (int i = 0; i < 16; ++i) { s0[i] = __builtin_amdgcn_exp2f(s0[i]); s1[i] = __builtin_amdgcn_exp2f(s1[i]); rsum += s0[i] + s1[i]; }
    rsum += __shfl_xor(rsum, 32, 64);
    lsum += rsum;
#pragma unroll
    for (int mt = 0; mt < 2; ++mt) {
#pragma unroll
      for (int s = 0; s < 2; ++s) {
        union { bf16x8 v; unsigned u[4]; } pk;
        if (mt == 0) {
          pk.u[0] = pack2(s0[8 * s + 0], s0[8 * s + 1]); pk.u[1] = pack2(s0[8 * s + 2], s0[8 * s + 3]);
          pk.u[2] = pack2(s0[8 * s + 4], s0[8 * s + 5]); pk.u[3] = pack2(s0[8 * s + 6], s0[8 * s + 7]);
        } else {
          pk.u[0] = pack2(s1[8 * s + 0], s1[8 * s + 1]); pk.u[1] = pack2(s1[8 * s + 2], s1[8 * s + 3]);
          pk.u[2] = pack2(s1[8 * s + 4], s1[8 * s + 5]); pk.u[3] = pack2(s1[8 * s + 6], s1[8 * s + 7]);
        }
        const int base = mt * 32 + s * 16 + 4 * h;
        union { bf16x8 v; uint2 u[2]; } va, vb;
        va.u[0] = *(const uint2*)(sV + r * VSTR + base);
        va.u[1] = *(const uint2*)(sV + r * VSTR + base + 8);
        vb.u[0] = *(const uint2*)(sV + (32 + r) * VSTR + base);
        vb.u[1] = *(const uint2*)(sV + (32 + r) * VSTR + base + 8);
        o0 = MFMA32(va.v, pk.v, o0);
        o1 = MFMA32(vb.v, pk.v, o1);
      }
    }
  }
#undef TILE_K0
#undef ALOAD
#undef ASTORE
  float lt = lsum;
  if (has_sink) lt += __builtin_amdgcn_exp2f(sink_l2 - m);
  const float inv = 1.f / lt;
  bf16_t* yp = Y + ((size_t)b * TT + qpos) * DM + ycol;
#pragma unroll
  for (int g = 0; g < 4; ++g) {
    uint2 u0, u1;
    u0.x = pack2(o0[4 * g] * inv, o0[4 * g + 1] * inv); u0.y = pack2(o0[4 * g + 2] * inv, o0[4 * g + 3] * inv);
    u1.x = pack2(o1[4 * g] * inv, o1[4 * g + 1] * inv); u1.y = pack2(o1[4 * g + 2] * inv, o1[4 * g + 3] * inv);
    *(uint2*)(yp + 8 * g + 4 * h) = u0;
    *(uint2*)(yp + 32 + 8 * g + 4 * h) = u1;
  }
}

template <int DQK>
DI void attn_item2(char* smem, const bf16_t* __restrict__ Q, const bf16_t* __restrict__ K, const bf16_t* __restrict__ VT,
                   int qh, int kvh, int b, int q0, bf16_t* __restrict__ Y, int ycol) {
  constexpr int KS = DQK / 16, KSTR = DQK + 8, VSTR = 72, KV8 = DQK / 8;
  const int tid = tid_(), w = tid >> 6, l = tid & 63, r = l & 31, h = l >> 5;
  bf16x8 qf[2][KS];
#pragma unroll
  for (int qn = 0; qn < 2; ++qn) {
    const bf16_t* qp = Q + ((size_t)qh * TT + q0 + w * 64 + qn * 32 + r) * DQK + 8 * h;
#pragma unroll
    for (int ks = 0; ks < KS; ++ks) qf[qn][ks] = *(const bf16x8*)(qp + ks * 16);
  }
  f32x16 o[2][2];
#pragma unroll
  for (int qn = 0; qn < 2; ++qn)
#pragma unroll
    for (int i = 0; i < 16; ++i) { o[qn][0][i] = 0; o[qn][1][i] = 0; }
  float m[2] = {0.f, 0.f}, lsum[2] = {0.f, 0.f};
  const int ntiles = TT / 64;
  const bf16_t* Kb = K + (size_t)kvh * TT * DQK;
  const bf16_t* Vb = VT + (size_t)kvh * 64 * TT;
  constexpr bool K2 = (64 * KV8) > NTHR;
  constexpr int BUFE = 64 * KSTR + 64 * VSTR;
  uint4 kr0, kr1, vr0;
  kr1 = make_uint4(0, 0, 0, 0);
  const int kidx1 = K2 ? min(tid + NTHR, 64 * KV8 - 1) : 0;
  const int krow0 = tid / KV8, kcc0 = tid - krow0 * KV8, krow1 = kidx1 / KV8, kcc1 = kidx1 - krow1 * KV8;
  const int vrow0 = tid >> 3, vcc0 = tid & 7;
#define ALOAD(i) { const int kk0 = (i) * 64; \
    kr0 = *(const uint4*)(Kb + (size_t)(kk0 + krow0) * DQK + kcc0 * 8); \
    if (K2) kr1 = *(const uint4*)(Kb + (size_t)(kk0 + krow1) * DQK + kcc1 * 8); \
    vr0 = *(const uint4*)(Vb + (size_t)vrow0 * TT + kk0 + vcc0 * 8); }
#define ASTORE(bb) { bf16_t* dK = (bf16_t*)smem + (bb) * BUFE; bf16_t* dV = dK + 64 * KSTR; \
    *(uint4*)(dK + krow0 * KSTR + kcc0 * 8) = kr0; \
    if (K2) *(uint4*)(dK + krow1 * KSTR + kcc1 * 8) = kr1; \
    *(uint4*)(dV + vrow0 * VSTR + vcc0 * 8) = vr0; }
  ALOAD(0)
  __syncthreads();
  ASTORE(0)
  ALOAD(1)
  for (int it = 0; it < ntiles; ++it) {
    __syncthreads();
    ASTORE((it + 1) & 1)
    __builtin_amdgcn_sched_barrier(0);
    ALOAD(min(it + 2, ntiles - 1))
    __builtin_amdgcn_sched_barrier(0);
    const bf16_t* sK = (const bf16_t*)smem + (it & 1) * BUFE;
    const bf16_t* sV = sK + 64 * KSTR;
    f32x16 s[2][2];
#pragma unroll
    for (int qn = 0; qn < 2; ++qn) {
      const float ninit = -m[qn];
#pragma unroll
      for (int i = 0; i < 16; ++i) { s[qn][0][i] = ninit; s[qn][1][i] = ninit; }
    }
#pragma unroll
    for (int ks = 0; ks < KS; ++ks) {
      bf16x8 a0 = *(const bf16x8*)(sK + r * KSTR + ks * 16 + 8 * h);
      bf16x8 a1 = *(const bf16x8*)(sK + (32 + r) * KSTR + ks * 16 + 8 * h);
#pragma unroll
      for (int qn = 0; qn < 2; ++qn) {
        s[qn][0] = MFMA32(a0, qf[qn][ks], s[qn][0]);
        s[qn][1] = MFMA32(a1, qf[qn][ks], s[qn][1]);
      }
    }
    int mxb = __float_as_int(s[0][0][0]);
#pragma unroll
    for (int qn = 0; qn < 2; ++qn)
#pragma unroll
      for (int i = 0; i < 16; ++i) mxb = max(mxb, max(__float_as_int(s[qn][0][i]), __float_as_int(s[qn][1][i])));
    if (__any((it == 0) || (mxb > 0x41000000))) {
#pragma unroll
      for (int qn = 0; qn < 2; ++qn) {
        float mx = -1e30f;
#pragma unroll
        for (int i = 0; i < 16; ++i) mx = fmaxf(mx, fmaxf(s[qn][0][i], s[qn][1][i]));
        mx = fmaxf(mx, __shfl_xor(mx, 32, 64));
        const float delta = (it == 0) ? mx : fmaxf(mx, 0.f);
        const float alpha = (it == 0) ? 1.f : __builtin_amdgcn_exp2f(-delta);
        m[qn] += delta;
        lsum[qn] *= alpha;
#pragma unroll
        for (int i = 0; i < 16; ++i) { o[qn][0][i] *= alpha; o[qn][1][i] *= alpha; s[qn][0][i] -= delta; s[qn][1][i] -= delta; }
      }
    }
#pragma unroll
    for (int mt = 0; mt < 2; ++mt) {
#pragma unroll
      for (int qn = 0; qn < 2; ++qn) {
        float rsum = 0;
#pragma unroll
        for (int i = 0; i < 16; ++i) { s[qn][mt][i] = __builtin_amdgcn_exp2f(s[qn][mt][i]); rsum += s[qn][mt][i]; }
        lsum[qn] += rsum;
      }
#pragma unroll
      for (int sx = 0; sx < 2; ++sx) {
        const int base = mt * 32 + sx * 16 + 4 * h;
        union { bf16x8 v; uint2 u[2]; } va, vb;
        va.u[0] = *(const uint2*)(sV + r * VSTR + base);
        va.u[1] = *(const uint2*)(sV + r * VSTR + base + 8);
        vb.u[0] = *(const uint2*)(sV + (32 + r) * VSTR + base);
        vb.u[1] = *(const uint2*)(sV + (32 + r) * VSTR + base + 8);
#pragma unroll
        for (int qn = 0; qn < 2; ++qn) {
          union { bf16x8 v; unsigned u[4]; } pk;
          pk.u[0] = pack2(s[qn][mt][8 * sx + 0], s[qn][mt][8 * sx + 1]); pk.u[1] = pack2(s[qn][mt][8 * sx + 2], s[qn][mt][8 * sx + 3]);
          pk.u[2] = pack2(s[qn][mt][8 * sx + 4], s[qn][mt][8 * sx + 5]); pk.u[3] = pack2(s[qn][mt][8 * sx + 6], s[qn][mt][8 * sx + 7]);
          o[qn][0] = MFMA32(va.v, pk.v, o[qn][0]);
          o[qn][1] = MFMA32(vb.v, pk.v, o[qn][1]);
        }
      }
    }
  }
#undef ALOAD
#undef ASTORE
#pragma unroll
  for (int qn = 0; qn < 2; ++qn) {
    const float lt = lsum[qn] + __shfl_xor(lsum[qn], 32, 64);
    const float inv = 1.f / lt;
    bf16_t* yp = Y + ((size_t)b * TT + q0 + w * 64 + qn * 32 + r) * DM + ycol;
#pragma unroll
    for (int g = 0; g < 4; ++g) {
      uint2 u0, u1;
      u0.x = pack2(o[qn][0][4 * g] * inv, o[qn][0][4 * g + 1] * inv); u0.y = pack2(o[qn][0][4 * g + 2] * inv, o[qn][0][4 * g + 3] * inv);
      u1.x = pack2(o[qn][1][4 * g] * inv, o[qn][1][4 * g + 1] * inv); u1.y = pack2(o[qn][1][4 * g + 2] * inv, o[qn][1][4 * g + 3] * inv);
      *(uint2*)(yp + 8 * g + 4 * h) = u0;
      *(uint2*)(yp + 32 + 8 * g + 4 * h) = u1;
    }
  }
}

DI void phase_C(char* smem, const Params& p, int layer) {
  const int J_S5 = 16, J_HG = 256, J_SWA = NBATCH * 4 * 33;
  const int G = gridDim.x;
  for (int j = bid_(); j < J_S5; j += G) {
    const int gid = j * NTHR + tid_();
    const int pp = gid & 63, dirn = (gid >> 6) & 1, g = (gid >> 7) & 15, b = gid >> 11;
    const int jb = (layer * 2 + dirn) * 16 + g;
    const float ar = p.apow[((size_t)jb * 33 + 32) * 128 + pp * 2], ai = p.apow[((size_t)jb * 33 + 32) * 128 + pp * 2 + 1];
    float sr = 0, si = 0;
    float* base = p.Es5 + ((size_t)b * NCH * 16 + g) * 256 + dirn * 128 + pp * 2;
#define MCH(n) (dirn == 0 ? (n) : ((n) < 8 ? 7 - (n) : 271 - (n)))
#pragma unroll 1
    for (int n0 = 0; n0 < NCH; n0 += 44) {
      float2 e[44];
#pragma unroll
      for (int u = 0; u < 44; ++u) e[u] = *(const float2*)(base + (size_t)MCH(n0 + u) * 4096);
#pragma unroll
      for (int u = 0; u < 44; ++u) {
        *(float2*)(base + (size_t)MCH(n0 + u) * 4096) = make_float2(sr, si);
        const float nr = ar * sr - ai * si + e[u].x, ni = ar * si + ai * sr + e[u].y;
        sr = nr; si = ni;
      }
    }
#undef MCH
  }
  for (int j = bid_(); j < J_HG; j += G) {
    const int gid = j * NTHR + tid_();
    const int chain = gid >> 12, e = gid & 4095, d = e & 63;
    float* base = p.Eh + (size_t)chain * NSC * 4096 + e;
    const float* db = p.dech + (size_t)chain * NSC * 64 + d;
    float s = 0;
#pragma unroll 1
    for (int n0 = 0; n0 < NSC; n0 += 22) {
      float ev[22], dv[22];
#pragma unroll
      for (int u = 0; u < 22; ++u) { ev[u] = base[(size_t)(n0 + u) * 4096]; dv[u] = db[(n0 + u) * 64]; }
#pragma unroll
      for (int u = 0; u < 22; ++u) { base[(size_t)(n0 + u) * 4096] = s; s = dv[u] * s + ev[u]; }
    }
  }
  {
    const int nb = G > 32 ? G - 16 : G, me = G > 32 ? bid_() - 16 : bid_();
    if (me >= 0) {
      for (int j = me; j < J_SWA; j += nb) {
        const int qt = j % 33, bh = j / 33, hd = bh & 3, b = bh >> 2;
        attn_item<64, true>(smem, p.Qs, p.Ks, p.VsT, b * 4 + hd, b * 2 + (hd >> 1), b, qt * 256, true,
                            p.sink[layer * 4 + hd] * LOG2E, p.Hn, 256 + hd * 64);
      }
    }
  }
}

DI void phase_D(char* smem, const Params& p, int layer) {
  const int J_MLA = 256 + 16, J_RD = 16 * 5 * 2, J_HG = NBATCH * 4 * 2 * NSC / 2;
  const int G = gridDim.x;
  for (int j = bid_(); j < J_MLA; j += G) {
    if (j < 256) {
      const int rest = j >> 3, bh = (j & 7) + 8 * (rest >> 4), qt = rest & 15;
      attn_item2<96>(smem, p.Qm, p.Km, p.VmT, bh, bh, bh >> 2, CTXL + qt * 512, p.Hn, 768 + (bh & 3) * 64);
    } else {
      const int bh = j - 256;
      attn_item<96, false>(smem, p.Qm, p.Km, p.VmT, bh, bh, bh >> 2, 0, false, 0.f, p.Hn, 768 + (bh & 3) * 64);
    }
  }
  for (int j = (bid_() + G - (J_MLA % G)) % G; j < J_RD; j += G) {
    const int g = j / 10, q = j % 10, mt = q >> 1, nt = q & 1;
    const bf16_t* Pu = p.Pu; const float* Es = p.Es5;
    auto al = [=](int row, int k) -> uint4 {
      row = min(row, NCHR - 1);
      if (k < 512) return *(const uint4*)(Pu + ((size_t)row * 32 + (k >> 4)) * 256 + g * 16 + (k & 15));
      const float* e = Es + ((size_t)row * 16 + g) * 256 + (k - 512);
      float4 a = *(const float4*)e, c = *(const float4*)(e + 4);
      return make_uint4(pack2(a.x, a.y), pack2(a.z, a.w), pack2(c.x, c.y), pack2(c.z, c.w));
    };
    bf16_t* Yg = p.Yg;
    auto ep = [=](int row, int col, float v0, float v1, float v2, float v3) {
      if (row >= NCHR) return;
      const int t = col >> 4, hh = col & 15;
      auto gelu = [](float v) {
        const float u = 0.7978845608028654f * (v + 0.044715f * v * v * v);
        const float th = 1.f - 2.f * __builtin_amdgcn_rcpf(1.f + __expf(2.f * u));
        return 0.5f * v * (1.f + th);
      };
      *(uint2*)(Yg + ((size_t)row * 32 + t) * 256 + g * 16 + hh) = make_uint2(pack2(gelu(v0), gelu(v1)), pack2(gelu(v2), gelu(v3)));
    };
    gemm_tile(smem, al, p.TW + (size_t)(layer * 16 + g) * 512 * 768, 768, 512, ep, mt * 256, nt * 256, 768);
  }
  for (int j = (bid_() + G - ((J_MLA + J_RD) % G)) % G; j < J_HG; j += G) hg_item<true>(smem, p, layer, j);
}

DI void phase_E(char* smem, const Params& p, int layer) {
  const int J_GLU = 132, J_FIN = R / 16;
  const int G = gridDim.x;
  for (int j = bid_(); j < J_GLU; j += G) {
    const int mt = j, nt = 0;
    const bf16_t* Yg = p.Yg; bf16_t* Hn = p.Hn; const float* bg = p.b_glu + layer * 256;
    auto al = [=](int row, int k) -> uint4 { return *(const uint4*)(Yg + (size_t)row * 256 + k); };
    auto ep = [=](int row, int col, float v0, float v1, float v2, float v3) {
      const uint2 yy = *(const uint2*)(Yg + (size_t)row * 256 + col);
      const float4 bb = *(const float4*)(bg + col);
      const float y0 = __uint_as_float(yy.x << 16), y1 = __uint_as_float(yy.x & 0xffff0000u);
      const float y2 = __uint_as_float(yy.y << 16), y3 = __uint_as_float(yy.y & 0xffff0000u);
      *(uint2*)(Hn + (size_t)row * DM + col) = make_uint2(pack2(y0 * fsigmoid(v0 + bb.x), y1 * fsigmoid(v1 + bb.y)),
                                                         pack2(y2 * fsigmoid(v2 + bb.z), y3 * fsigmoid(v3 + bb.w)));
    };
    gemm_tile_dma<4>(smem, p.Yg, 256, p.Wg + (size_t)layer * 65536, 256, 256, ep, mt * 256, nt * 256, 256);
  }
  for (int j = (bid_() + G - (J_GLU % G)) % G; j < J_FIN; j += G) {
    const int w = (tid_() >> 6) & 3, rsel = tid_() >> 8, l = tid_() & 63;
    const float gn = p.hg_norm_g[layer * 64 + l];
#pragma unroll
    for (int rr = 0; rr < 8; ++rr) {
      const int row = j * 16 + rr * 2 + rsel;
      const float o = bf2f(p.OF[(size_t)row * 256 + w * 64 + l]) + bf2f(p.OB[(size_t)row * 256 + w * 64 + l]);
      const float ss = wave_sum(o * o);
      const float rs = rsqrtf(ss * (1.f / 64.f) + EPSN);
      const float gt = bf2f(p.PH[(size_t)row * 1280 + 1024 + w * 64 + l]);
      p.Hn[(size_t)row * DM + 512 + w * 64 + l] = f2bf(o * rs * gn * gt * sigmoidf_(gt));
    }
  }
}

DI void phase_resid(char* smem, const Params& p, int layer, const bf16_t* A, int K, const bf16_t* W, int gate_idx, bool first) {
  auto al = [=](int row, int k) -> uint4 { return *(const uint4*)(A + (size_t)row * K + k); };
  auto ep = [&](int row, int col, float v0, float v1, float v2, float v3) {
    const int b = row / TT, t = row - b * TT;
    const float4 g = *(const float4*)(p.mod + (size_t)(layer * 5 + (t < CTXL ? 4 : b)) * 6144 + gate_idx * 1024 + col);
    const float4 xo = *(const float4*)(xsrc_row(p, first, row) + col);
    *(float4*)(xdst_row(p, row) + col) = make_float4(xo.x + g.x * v0, xo.y + g.y * v1, xo.z + g.z * v2, xo.w + g.w * v3);
  };
  for_tiles_xcd<1>(R / 256, 4, [&](int m0, int nt, auto mi) { gemm_tile_dma<decltype(mi)::value>(smem, A, K, W, K, DM, ep, m0, nt * 256, K); });
}

DI void phase_ffn_up(char* smem, const Params& p, int layer) {
  const bf16_t* Hn = p.Hn;
  auto al = [=](int row, int k) -> uint4 { return *(const uint4*)(Hn + (size_t)row * DM + k); };
  bf16_t* Hh = p.H;
  auto ep = [=](int row, int cb, int q4, const f32x4& c0, const f32x4& c1, const f32x4& c2, const f32x4& c3) {
    const uint4 o = make_uint4(pack2(c0[0] * fsigmoid(c0[0]) * c0[1], c0[2] * fsigmoid(c0[2]) * c0[3]),
                               pack2(c1[0] * fsigmoid(c1[0]) * c1[1], c1[2] * fsigmoid(c1[2]) * c1[3]),
                               pack2(c2[0] * fsigmoid(c2[0]) * c2[1], c2[2] * fsigmoid(c2[2]) * c2[3]),
                               pack2(c3[0] * fsigmoid(c3[0]) * c3[1], c3[2] * fsigmoid(c3[2]) * c3[3]));
    *(uint4*)(Hh + (size_t)row * FH + (cb >> 1) + q4 * 8) = o;
  };
  const bf16_t* W = p.Wu + (size_t)layer * 2 * FH * DM;
  for_tiles_xcd<2>(R / 256, 22, [&](int m0, int nt, auto mi) { gemm_tile_dma<decltype(mi)::value>(smem, Hn, DM, W, DM, 2 * FH, ep, m0, nt * 256, DM); });
}

constexpr int N_PHASES = 2 + 10 * DEPTH;

__global__ void __launch_bounds__(512, 2) mega(Params p, int ph_lo, int ph_hi) {
  extern __shared__ __attribute__((aligned(16))) char smem[];
  for (int ph = ph_lo; ph < ph_hi; ++ph) {
    if (ph == 0) phase_prep(smem, p);
    else if (ph == 1) { phase_s5mats(p); phase_norm(p, 0, 0, true); }
    else {
      const int layer = (ph - 2) / 10, s = (ph - 2) % 10;
      const bool first = layer == 0;
      switch (s) {
        case 0: phase_win(smem, p, layer); break;
        case 1: phase_B(smem, p, layer); break;
        case 2: phase_C(smem, p, layer); break;
        case 3: phase_D(smem, p, layer); break;
        case 4: phase_E(smem, p, layer); break;
        case 5: phase_resid(smem, p, layer, p.Hn, DM, p.Wo + (size_t)layer * DM * DM, 2, first); break;
        case 6: phase_norm(p, layer, 1, false); break;
        case 7: phase_ffn_up(smem, p, layer); break;
        case 8: phase_resid(smem, p, layer, p.H, FH, p.Wd + (size_t)layer * DM * FH, 5, false); break;
        default:
          if (layer + 1 < DEPTH) phase_norm(p, layer + 1, 0, false); else phase_final_norm(p);
          break;
      }
    }
    if (ph + 1 < ph_hi) grid_barrier(p.bar, (unsigned)(ph - ph_lo + 1));
  }
}

extern "C" void kernel_launch(void* const* d_in, const int* in_sizes, int n_in, void* d_out, int out_size, void* d_ws,
                              size_t ws_size, hipStream_t stream) {
  static int grid_blocks = 0;
  if (!grid_blocks) {
    int dev = 0, cus = 0, per_cu = 0;
    hipGetDevice(&dev);
    hipDeviceGetAttribute(&cus, hipDeviceAttributeMultiprocessorCount, dev);
    hipFuncSetAttribute((const void*)mega, hipFuncAttributeMaxDynamicSharedMemorySize, LDS_BYTES);
    hipOccupancyMaxActiveBlocksPerMultiprocessor(&per_cu, (const void*)mega, NTHR, LDS_BYTES);
    (void)per_cu;
    grid_blocks = cus;
  }
  Params p{};
  const float** ins = (const float**)&p;
  for (int i = 0; i < 30; ++i) ins[i] = (const float*)d_in[i];
  p.out = (float*)d_out;
  char* ws = (char*)d_ws;
  size_t off = 0;
  auto take = [&](size_t bytes) { char* q = ws + off; off += (bytes + 255) & ~(size_t)255; return q; };
  p.bar = (unsigned*)take(8192);
  p.Xc = (float*)take((size_t)NBATCH * CTXL * DM * 4);
  p.mod = (float*)take((size_t)DEPTH * 5 * 6144 * 4);
  p.lb = (float*)take(2 * 4 * 256 * 4);
  p.ropeS = (float*)take(128 * 16 * 2 * 4);
  p.ropeM = (float*)take(128 * 8 * 2 * 4);
  p.apow = (float*)take((size_t)J_S5TAB * 33 * 128 * 4);
  p.bbar = (float*)take((size_t)J_S5TAB * 64 * 16 * 2 * 4);
  p.Ktab = (float*)take((size_t)J_S5TAB * 32 * 256 * 4);
  p.Wi = (bf16_t*)take((size_t)DEPTH * NINP * DM * 2);
  p.Wo = (bf16_t*)take((size_t)DEPTH * DM * DM * 2);
  p.Wu = (bf16_t*)take((size_t)DEPTH * 2 * FH * DM * 2);
  p.Wd = (bf16_t*)take((size_t)DEPTH * DM * FH * 2);
  p.Wg = (bf16_t*)take((size_t)DEPTH * 65536 * 2);
  p.Wq = (bf16_t*)take((size_t)DEPTH * 384 * 256 * 2);
  p.Wkv = (bf16_t*)take((size_t)DEPTH * 512 * 128 * 2);
  p.TW = (bf16_t*)take((size_t)DEPTH * 16 * 512 * 768 * 2);
  p.W1 = (bf16_t*)take((size_t)DEPTH * 16 * 256 * 512 * 2);
  p.Hn = (bf16_t*)take((size_t)R * DM * 2);
  const size_t big0 = off;
  p.Pu = (bf16_t*)take((size_t)R * 256 * 2);
  p.PH = (bf16_t*)take((size_t)R * 1280 * 2);
  p.Es5 = (float*)take((size_t)NCHR * 16 * 256 * 4);
  p.Eh = (float*)take((size_t)NBATCH * 4 * 2 * NSC * 4096 * 4);
  p.dech = (float*)take((size_t)NBATCH * 4 * 2 * NSC * 64 * 4);
  p.Qm = (bf16_t*)take((size_t)R * 4 * 96 * 2);
  p.Km = (bf16_t*)take((size_t)R * 4 * 96 * 2);
  p.VmT = (bf16_t*)take((size_t)R * 256 * 2);
  const size_t al0 = off;
  p.Pm = (bf16_t*)take((size_t)R * 384 * 2);
  p.Qs = (bf16_t*)take((size_t)R * 256 * 2);
  p.Ks = (bf16_t*)take((size_t)R * 128 * 2);
  p.VsT = (bf16_t*)take((size_t)R * 128 * 2);
  const size_t end1 = off;
  off = al0;
  p.Yg = (bf16_t*)take((size_t)R * 256 * 2);
  p.OF = (bf16_t*)take((size_t)R * 256 * 2);
  p.OB = (bf16_t*)take((size_t)R * 256 * 2);
  size_t end2 = off;
  p.H = (bf16_t*)(ws + big0);
  size_t endH = big0 + (size_t)R * FH * 2;
  size_t total = end1 > end2 ? end1 : end2;
  if (endH > total) total = endH;
  if (total > ws_size) { fprintf(stderr, "kernel_launch: workspace too small: need %zu, have %zu\n", total, ws_size); return; }
  if (hipMemsetAsync(p.bar, 0, 8192, stream) != hipSuccess) { fprintf(stderr, "memset failed\n"); return; }
  int lo = 0, hi = N_PHASES;
  void* args[] = {&p, &lo, &hi};
  hipError_t e = hipLaunchCooperativeKernel((const void*)mega, dim3(grid_blocks), dim3(NTHR), args, LDS_BYTES, stream);
  if (e != hipSuccess) fprintf(stderr, "cooperative launch failed: %s (grid %d)\n", hipGetErrorString(e), grid_blocks);
}
```

```cpp
#include <hip/hip_runtime.h>
#include <hip/hip_cooperative_groups.h>
#include <cstdio>
#include <type_traits>
namespace cg = cooperative_groups;

#define DI __device__ __forceinline__
typedef unsigned short bf16_t;
using bf16x8 = __attribute__((ext_vector_type(8))) short;
using f32x16 = __attribute__((ext_vector_type(16))) float;
using f32x4  = __attribute__((ext_vector_type(4))) float;

constexpr int DM = 1024, NBATCH = 4, SEQ = 8192, CTXL = 256, TT = SEQ + CTXL, R = NBATCH * TT, DEPTH = 4;
constexpr int NIN = 2464, FH = 2816;
constexpr int NINP = 2496;
constexpr int NCH = TT / 32;
constexpr int NCHR = NBATCH * NCH;
constexpr int NSC = TT / 128;
constexpr float LOG2E = 1.4426950408889634f;
constexpr float EPSN = 1e-6f;
constexpr int NTHR = 512;
constexpr int LDS_BYTES = 147456 + 1024;

#define MFMA32(a, b, c) __builtin_amdgcn_mfma_f32_32x32x16_bf16((a), (b), (c), 0, 0, 0)
#define MFMA16(a, b, c) __builtin_amdgcn_mfma_f32_16x16x32_bf16((a), (b), (c), 0, 0, 0)

DI int tid_() { int t = threadIdx.x; asm volatile("" : "+v"(t)); return t; }
DI int bid_() { int b = blockIdx.x; asm volatile("" : "+s"(b)); return b; }
typedef __bf16 hwbf2_t __attribute__((ext_vector_type(2)));
typedef float hwf2_t __attribute__((ext_vector_type(2)));
DI unsigned pack2(float a, float b) { hwf2_t f = {a, b}; return __builtin_bit_cast(unsigned, __builtin_convertvector(f, hwbf2_t)); }
DI bf16_t f2bf(float x) { return (bf16_t)(pack2(x, 0.f) & 0xffffu); }
DI float bf2f(bf16_t b) { return __uint_as_float(((unsigned)b) << 16); }
DI int crow(int reg, int h) { return (reg & 3) + 8 * (reg >> 2) + 4 * h; }
DI float sigmoidf_(float x) { return 1.f / (1.f + expf(-x)); }
DI float fsigmoid(float x) { return __builtin_amdgcn_rcpf(1.f + __expf(-x)); }
DI float wave_sum(float v) {
#pragma unroll
  for (int o = 32; o > 0; o >>= 1) v += __shfl_xor(v, o, 64);
  return v;
}


DI void my_sincos(float x, float* sn, float* cs) {
  const float q = rintf(x * 0.6366197723675814f);
  float r = fmaf(-q, 1.5707962512969971f, x);
  r = fmaf(-q, 7.549789415861596e-08f, r);
  r = fmaf(-q, 5.390302529957765e-15f, r);
  const float r2 = r * r;
  const float sp = r + r * r2 * (-1.6666667e-1f + r2 * (8.3333333e-3f + r2 * (-1.98412698e-4f + r2 * 2.7557319e-6f)));
  const float cp = 1.f + r2 * (-0.5f + r2 * (4.1666667e-2f + r2 * (-1.3888889e-3f + r2 * (2.48015873e-5f - r2 * 2.7557319e-7f))));
  const int qi = ((int)q) & 3;
  const float s_ = (qi & 1) ? cp : sp, c_ = (qi & 1) ? sp : cp;
  *sn = (qi < 2) ? s_ : -s_;
  *cs = (qi == 0 || qi == 3) ? c_ : -c_;
}

struct Params {
  const float *x, *c, *ctx, *c_ctx, *w_mod, *b_mod, *norm1_g, *norm2_g, *w_in, *w_out;
  const float *lam_re, *lam_im, *log_dt, *b_re, *b_im, *c_re, *c_im, *s5_d, *w_glu, *b_glu;
  const float *sink, *hg_lb, *hg_norm_g, *q_norm_g, *w_qb, *kv_norm_g, *w_kvb, *w_up, *w_down, *final_g;
  float* out;
  float *Xc, *mod, *lb, *ropeS, *ropeM, *apow, *bbar, *Ktab;
  bf16_t *Wi, *Wo, *Wu, *Wd, *Wg, *Wq, *Wkv, *TW, *W1;
  bf16_t *Hn;
  bf16_t *H;
  bf16_t *Pu, *PH, *Pm, *Qs, *Ks, *VsT, *Qm, *Km, *VmT, *Yg, *OF, *OB;
  float *Es5, *Eh, *dech;
  unsigned* bar;
};


DI void grid_barrier(unsigned* bar, unsigned ep) {
  asm volatile("s_waitcnt vmcnt(0)" ::: "memory");
  __syncthreads();
  if (threadIdx.x == 0) {
    const unsigned G = gridDim.x, g = blockIdx.x & 7u, nloc = (G - g + 7u) >> 3, ng = G < 8u ? G : 8u;
    __builtin_amdgcn_fence(__ATOMIC_RELEASE, "agent");
    asm volatile("s_waitcnt vmcnt(0)" ::: "memory");
    const unsigned old = __hip_atomic_fetch_add(&bar[64 * g], 1u, __ATOMIC_RELAXED, __HIP_MEMORY_SCOPE_AGENT);
    if (old + 1u == ep * nloc) {
      const unsigned og = __hip_atomic_fetch_add(&bar[1024], 1u, __ATOMIC_RELAXED, __HIP_MEMORY_SCOPE_AGENT);
      if (og + 1u == ep * ng) __hip_atomic_store(&bar[1088], ep, __ATOMIC_RELAXED, __HIP_MEMORY_SCOPE_AGENT);
      else while (__hip_atomic_load(&bar[1088], __ATOMIC_RELAXED, __HIP_MEMORY_SCOPE_AGENT) < ep) __builtin_amdgcn_s_sleep(1);
      __hip_atomic_store(&bar[512 + 64 * g], ep, __ATOMIC_RELAXED, __HIP_MEMORY_SCOPE_AGENT);
    } else {
      while (__hip_atomic_load(&bar[512 + 64 * g], __ATOMIC_RELAXED, __HIP_MEMORY_SCOPE_AGENT) < ep) __builtin_amdgcn_s_sleep(1);
    }
    __builtin_amdgcn_fence(__ATOMIC_ACQUIRE, "agent");
    asm volatile("s_waitcnt vmcnt(0)" ::: "memory");
  }
  __syncthreads();
}

DI const float* xsrc_row(const Params& p, bool first, int row) {
  int b = row / TT, t = row - b * TT;
  if (t < CTXL) return (first ? p.ctx : p.Xc) + ((size_t)b * CTXL + t) * DM;
  return (first ? p.x : p.out) + ((size_t)b * SEQ + (t - CTXL)) * DM;
}
DI float* xdst_row(const Params& p, int row) {
  int b = row / TT, t = row - b * TT;
  if (t < CTXL) return p.Xc + ((size_t)b * CTXL + t) * DM;
  return p.out + ((size_t)b * SEQ + (t - CTXL)) * DM;
}

DI int perm_col(int kind, int n) {
  if (kind == 0) {
    { const int c = n & 63; n = (n & ~63) + ((c >> 2) & 3) * 16 + ((c >> 4) & 3) * 4 + (c & 3); }
    if (n >= NIN) return -1;
    if (n >= 256 && n < 640) { int base = n & ~63, d = n & 63; int a = d >> 5, f = (d & 31) >> 1, hf = d & 1; return base + a * 32 + hf * 16 + f; }
    if (n >= 2432) { int e = n - 2432; int a = e >> 4, f = (e & 15) >> 1, hf = e & 1; return 2432 + a * 16 + hf * 8 + f; }
    return n;
  } else if (kind == 1) {
    int hd = n / 96, dd = n - hd * 96;
    if (dd >= 64) { int e = dd - 64; int a = e >> 4, f = (e & 15) >> 1, hf = e & 1; dd = 64 + a * 16 + hf * 8 + f; }
    return hd * 96 + dd;
  } else if (kind == 2) {
    const int grp = n >> 6, c = n & 63;
    const int nt = (c >> 4) & 3, q4 = (c >> 2) & 3, jj = c & 3;
    return (jj & 1) * FH + grp * 32 + q4 * 8 + nt * 2 + (jj >> 1);
  }
  return n;
}

template <int KT>
DI void conv_tile(float* tile, const float* __restrict__ src, int ldsrc, const float* __restrict__ rscale,
                  bf16_t* __restrict__ dst, int K, int n0, int k0, int kind) {
  const int j = tid_() & 31, i = tid_() >> 5;
  const int sc0 = perm_col(kind, n0 + j);
  const int sc = max(sc0, 0);
  const float scm = sc0 >= 0 ? 1.f : 0.f;
  constexpr int NL = KT / 16;
  float v[NL];
#pragma unroll
  for (int e = 0; e < NL; ++e) v[e] = src[(size_t)(k0 + i + 16 * e) * ldsrc + sc] * scm;
  if (rscale) {
#pragma unroll
    for (int e = 0; e < NL; ++e) v[e] *= rscale[k0 + i + 16 * e];
  }
#pragma unroll
  for (int e = 0; e < NL; ++e) tile[(i + 16 * e) * 33 + j] = v[e];
  __syncthreads();
  const int nn = tid_() >> 4, kq = (tid_() & 15) * 8;
#pragma unroll
  for (int ps = 0; ps < KT / 128; ++ps) {
    float o[8];
#pragma unroll
    for (int e = 0; e < 8; ++e) o[e] = tile[(ps * 128 + kq + e) * 33 + nn];
    *(uint4*)(dst + (size_t)(n0 + nn) * K + k0 + ps * 128 + kq) = make_uint4(pack2(o[0], o[1]), pack2(o[2], o[3]), pack2(o[4], o[5]), pack2(o[6], o[7]));
  }
  __syncthreads();
}

DI void mod_job(float* red, const float* __restrict__ sil, const Params& p, int jm) {
  const int l = jm / 192, cb = (jm % 192) * 32;
  const int j = tid_() & 31, ks = tid_() >> 5;
  const float* wm = p.w_mod + (size_t)l * DM * 6144 + cb + j;
  float a0 = 0, a1 = 0, a2 = 0, a3 = 0, a4 = 0;
  for (int k = ks * 64; k < ks * 64 + 64; ++k) {
    const float w = wm[(size_t)k * 6144];
    a0 += w * sil[k]; a1 += w * sil[1024 + k]; a2 += w * sil[2048 + k]; a3 += w * sil[3072 + k]; a4 += w * sil[4096 + k];
  }
  red[(ks * 32 + j) * 5 + 0] = a0; red[(ks * 32 + j) * 5 + 1] = a1; red[(ks * 32 + j) * 5 + 2] = a2;
  red[(ks * 32 + j) * 5 + 3] = a3; red[(ks * 32 + j) * 5 + 4] = a4;
  __syncthreads();
  if (tid_() < 160) {
    int b = tid_() >> 5, jj = tid_() & 31;
    float s = p.b_mod[l * 6144 + cb + jj];
    for (int q = 0; q < 16; ++q) s += red[(q * 32 + jj) * 5 + b];
    p.mod[(size_t)(l * 5 + b) * 6144 + cb + jj] = s;
  }
  __syncthreads();
}

DI void misc_job(const Params& p) {
  const int tid = tid_();
  if (tid < 256)
  for (int dirn = 0; dirn < 2; ++dirn) {
    float v[4], mx = -1e30f;
    for (int l = 0; l < 4; ++l) { v[l] = p.hg_lb[(dirn * 4 + l) * 256 + tid]; mx = fmaxf(mx, v[l]); }
    float s = 0; for (int l = 0; l < 4; ++l) { v[l] = expf(v[l] - mx); s += v[l]; }
    float cum = 0, first = 0;
    for (int l = 0; l < 4; ++l) { cum += v[l] / s; if (l == 0) first = cum; p.lb[(dirn * 4 + l) * 256 + tid] = cum - first; }
  }
  for (int e = tid; e < 128 * 16; e += NTHR) {
    int pos = e >> 4, f = e & 15;
    float inv = exp2f(-(float)f * (13.287712379549449f / 16.f));
    float ang = (float)pos * inv, sn, cs;
    my_sincos(ang, &sn, &cs);
    p.ropeS[2 * e] = cs; p.ropeS[2 * e + 1] = sn;
  }
  for (int e = tid; e < 128 * 8; e += NTHR) {
    int pos = e >> 3, f = e & 7;
    float inv = exp2f(-(float)f * (13.287712379549449f / 8.f));
    float ang = (float)pos * inv, sn, cs;
    my_sincos(ang, &sn, &cs);
    p.ropeM[2 * e] = cs; p.ropeM[2 * e + 1] = sn;
  }
}

DI void s5tab_job(float* sm, const Params& p, int jb) {
  float2* s_ap = (float2*)sm;
  float2* s_bb = s_ap + 33 * 64;
  float2* s_c = s_bb + 64 * 16;
  const int tid = tid_();
  if (tid < 64) {
    const int pi = jb * 64 + tid;
    float lr = p.lam_re[pi], li = p.lam_im[pi], dt = expf(p.log_dt[pi]);
    float zr = lr * dt, zi = li * dt;
#pragma unroll 1
    for (int t = 0; t <= 32; ++t) {
      float mag = expf((float)t * zr), ang = (float)t * zi, sn, cs;
      my_sincos(ang, &sn, &cs);
      float2 v = make_float2(mag * cs, mag * sn);
      s_ap[t * 64 + tid] = v;
      p.apow[((size_t)jb * 33 + t) * 128 + tid * 2] = v.x;
      p.apow[((size_t)jb * 33 + t) * 128 + tid * 2 + 1] = v.y;
    }
    float cr, ci;
    if (zr * zr + zi * zi < 0.01f) {
      float pr = 1.f, pi_ = 0.f, tr = 1.f, ti = 0.f;
#pragma unroll
      for (int n = 2; n <= 7; ++n) {
        const float nr = (tr * zr - ti * zi) / (float)n, ni = (tr * zi + ti * zr) / (float)n;
        tr = nr; ti = ni; pr += tr; pi_ += ti;
      }
      cr = dt * pr; ci = dt * pi_;
    } else {
      float sn1, cs1;
      my_sincos(zi, &sn1, &cs1);
      const float ar = expf(zr) * cs1 - 1.f, ai = expf(zr) * sn1;
      const float den = lr * lr + li * li;
      cr = (ar * lr + ai * li) / den; ci = (ai * lr - ar * li) / den;
    }
#pragma unroll 1
    for (int hh = 0; hh < 16; ++hh) {
      float br = p.b_re[(size_t)pi * 16 + hh], bi = p.b_im[(size_t)pi * 16 + hh];
      float2 v = make_float2(cr * br - ci * bi, cr * bi + ci * br);
      s_bb[tid * 16 + hh] = v;
      p.bbar[((size_t)pi * 16 + hh) * 2] = v.x; p.bbar[((size_t)pi * 16 + hh) * 2 + 1] = v.y;
    }
  }
  for (int e = tid; e < 1024; e += NTHR) s_c[e] = make_float2(p.c_re[(size_t)jb * 1024 + e], p.c_im[(size_t)jb * 1024 + e]);
  __syncthreads();
  const int hh = (tid >> 4) & 15, hp = tid & 15, th = tid >> 8;
#pragma unroll 1
  for (int t = th; t < 32; t += 2) {
    float acc = 0;
#pragma unroll 4
    for (int q = 0; q < 64; ++q) {
      float2 c = s_c[hh * 64 + q], a = s_ap[t * 64 + q], b = s_bb[q * 16 + hp];
      float wr = c.x * a.x - c.y * a.y, wi = c.x * a.y + c.y * a.x;
      acc += wr * b.x - wi * b.y;
    }
    p.Ktab[((size_t)jb * 32 + t) * 256 + (tid & 255)] = acc;
  }
  __syncthreads();
}

constexpr int J_MOD = 768;
constexpr int CT_WI = 78 * 4, CT_WO = 32 * 4, CT_WU = 176 * 4, CT_WD = 32 * 11, CT_WG = 8 * 1, CT_WQ = 12 * 1, CT_WKV = 16 * 1;
constexpr int CT_LAYER = CT_WI + CT_WO + CT_WU + CT_WD + CT_WG + CT_WQ + CT_WKV;
constexpr int J_CONV = CT_LAYER * DEPTH;
constexpr int J_S5TAB = DEPTH * 2 * 16;

DI void phase_prep(char* smem, const Params& p) {
  float* sm = (float*)smem;
  float* sil = (float*)(smem + 65536);
  for (int e = tid_(); e < 5 * 1024; e += NTHR) {
    const float c = e < 4096 ? p.c[e] : p.c_ctx[e - 4096];
    sil[e] = c * sigmoidf_(c);
  }
  __syncthreads();
  const int total = J_MOD + J_S5TAB + 1 + J_CONV;
  for (int job = bid_(); job < total; job += gridDim.x) {
    int j = job;
    if (j < J_MOD) { mod_job(sm, sil, p, j); continue; }
    j -= J_MOD;
    if (j < J_S5TAB) { s5tab_job(sm, p, j); continue; }
    j -= J_S5TAB;
    if (j < 1) { misc_job(p); continue; }
    j -= 1;
    const int l = j / CT_LAYER; int q = j - l * CT_LAYER;
    if (q < CT_WI) { int nt = q / 4, kt = q % 4; conv_tile<256>(sm, p.w_in + (size_t)l * DM * NIN, NIN, nullptr, p.Wi + (size_t)l * NINP * DM, DM, nt * 32, kt * 256, 0); continue; }
    q -= CT_WI;
    if (q < CT_WO) { int nt = q / 4, kt = q % 4; conv_tile<256>(sm, p.w_out + (size_t)l * DM * DM, DM, nullptr, p.Wo + (size_t)l * DM * DM, DM, nt * 32, kt * 256, 3); continue; }
    q -= CT_WO;
    if (q < CT_WU) { int nt = q / 4, kt = q % 4; conv_tile<256>(sm, p.w_up + (size_t)l * DM * 2 * FH, 2 * FH, nullptr, p.Wu + (size_t)l * 2 * FH * DM, DM, nt * 32, kt * 256, 2); continue; }
    q -= CT_WU;
    if (q < CT_WD) { int nt = q / 11, kt = q % 11; conv_tile<256>(sm, p.w_down + (size_t)l * FH * DM, DM, nullptr, p.Wd + (size_t)l * DM * FH, FH, nt * 32, kt * 256, 3); continue; }
    q -= CT_WD;
    if (q < CT_WG) { int nt = q, kt = 0; conv_tile<256>(sm, p.w_glu + (size_t)l * 65536, 256, nullptr, p.Wg + (size_t)l * 65536, 256, nt * 32, kt * 256, 3); continue; }
    q -= CT_WG;
    if (q < CT_WQ) { int nt = q, kt = 0; conv_tile<256>(sm, p.w_qb + (size_t)l * 256 * 384, 384, p.q_norm_g + l * 256, p.Wq + (size_t)l * 384 * 256, 256, nt * 32, kt * 256, 1); continue; }
    q -= CT_WQ;
    { int nt = q, kt = 0; conv_tile<128>(sm, p.w_kvb + (size_t)l * 128 * 512, 512, p.kv_norm_g + l * 128, p.Wkv + (size_t)l * 512 * 128, 128, nt * 32, kt * 128, 3); }
  }
}

DI void phase_s5mats(const Params& p) {
  const int TW_ROWS = DEPTH * 16 * 512, W1_ROWS = DEPTH * 16 * 256;
  const size_t n_tw = (size_t)TW_ROWS * 96, n_w1 = (size_t)W1_ROWS * 64;
  for (size_t e = (size_t)bid_() * NTHR + tid_(); e < n_tw + n_w1; e += (size_t)gridDim.x * NTHR) {
    float v[8];
    bf16_t* dst;
    if (e < n_tw) {
      const int row = (int)(e / 96), kg = (int)(e % 96);
      const int lg = row >> 9, n = row & 511, t = n >> 4, hh = n & 15;
      const int l = lg >> 4, g = lg & 15;
      const int k = kg * 8;
      dst = p.TW + (size_t)row * 768 + k;
      if (k < 512) {
        const int s = k >> 4, h0 = k & 15;
        const float* Kf = p.Ktab + ((size_t)((l * 2 + 0) * 16 + g) * 32) * 256;
        const float* Kb = p.Ktab + ((size_t)((l * 2 + 1) * 16 + g) * 32) * 256;
        const int ds = t - s, df = ds >= 0 ? ds : 0, db = ds <= 0 ? -ds : 0;
        const float mf = ds >= 0 ? 1.f : 0.f, mb = ds <= 0 ? 1.f : 0.f;
        const float4 f0 = *(const float4*)(Kf + df * 256 + hh * 16 + h0), f1 = *(const float4*)(Kf + df * 256 + hh * 16 + h0 + 4);
        const float4 b0 = *(const float4*)(Kb + db * 256 + hh * 16 + h0), b1 = *(const float4*)(Kb + db * 256 + hh * 16 + h0 + 4);
        v[0] = mf * f0.x + mb * b0.x; v[1] = mf * f0.y + mb * b0.y; v[2] = mf * f0.z + mb * b0.z; v[3] = mf * f0.w + mb * b0.w;
        v[4] = mf * f1.x + mb * b1.x; v[5] = mf * f1.y + mb * b1.y; v[6] = mf * f1.z + mb * b1.z; v[7] = mf * f1.w + mb * b1.w;
        if (ds == 0) {
          const float dsk = p.s5_d[l * 256 + g * 16 + hh];
#pragma unroll
          for (int j = 0; j < 8; ++j) if (hh == h0 + j) v[j] += dsk;
        }
      } else {
        const int dirn = (k - 512) >> 7, p0 = ((k - 512) & 127) >> 1;
        const int jb = (l * 2 + dirn) * 16 + g;
        const int ex = dirn == 0 ? t + 1 : 32 - t;
#pragma unroll
        for (int j = 0; j < 8; ++j) {
          const int pp = p0 + (j >> 1);
          float cr = p.c_re[((size_t)jb * 16 + hh) * 64 + pp], ci = p.c_im[((size_t)jb * 16 + hh) * 64 + pp];
          float ar = p.apow[((size_t)jb * 33 + ex) * 128 + pp * 2], ai = p.apow[((size_t)jb * 33 + ex) * 128 + pp * 2 + 1];
          v[j] = (j & 1) ? -(cr * ai + ci * ar) : (cr * ar - ci * ai);
        }
      }
    } else {
      const size_t e2 = e - n_tw;
      const int row = (int)(e2 / 64), kg = (int)(e2 % 64);
      const int lg = row >> 8, n = row & 255;
      const int l = lg >> 4, g = lg & 15;
      const int dirn = n >> 7, pp = (n & 127) >> 1, ri = n & 1;
      const int k = kg * 8, s = k >> 4, h0 = k & 15;
      const int jb = (l * 2 + dirn) * 16 + g;
      const int ex = dirn == 0 ? 31 - s : s;
      dst = p.W1 + (size_t)row * 512 + k;
      float ar = p.apow[((size_t)jb * 33 + ex) * 128 + pp * 2], ai = p.apow[((size_t)jb * 33 + ex) * 128 + pp * 2 + 1];
#pragma unroll
      for (int j = 0; j < 8; ++j) {
        float br = p.bbar[(((size_t)jb * 64 + pp) * 16 + h0 + j) * 2], bi = p.bbar[(((size_t)jb * 64 + pp) * 16 + h0 + j) * 2 + 1];
        v[j] = ri ? (ar * bi + ai * br) : (ar * br - ai * bi);
      }
    }
    uint4 o; o.x = pack2(v[0], v[1]); o.y = pack2(v[2], v[3]); o.z = pack2(v[4], v[5]); o.w = pack2(v[6], v[7]);
    *(uint4*)dst = o;
  }
}

DI void phase_norm(const Params& p, int layer, int which, bool first) {
  const int w = tid_() >> 6, l = tid_() & 63;
  const float* g = (which ? p.norm2_g : p.norm1_g) + layer * DM;
  for (int row = bid_() * 8 + w; row < R / 2; row += gridDim.x * 8) {
    float4 v[2][4]; float ss[2];
#pragma unroll
    for (int u = 0; u < 2; ++u) {
      const float* xr = xsrc_row(p, first, row + u * (R / 2));
      ss[u] = 0;
#pragma unroll
      for (int i = 0; i < 4; ++i) { v[u][i] = *(const float4*)(xr + i * 256 + l * 4); ss[u] += v[u][i].x * v[u][i].x + v[u][i].y * v[u][i].y + v[u][i].z * v[u][i].z + v[u][i].w * v[u][i].w; }
    }
#pragma unroll
    for (int u = 0; u < 2; ++u) {
      const int rw = row + u * (R / 2);
      const int b = rw / TT, t = rw - b * TT;
      const float* md = p.mod + (size_t)(layer * 5 + (t < CTXL ? 4 : b)) * 6144 + which * 3072;
      const float rs = rsqrtf(wave_sum(ss[u]) * (1.f / DM) + EPSN);
#pragma unroll
      for (int i = 0; i < 4; ++i) {
        const int c = i * 256 + l * 4;
        float4 gg = *(const float4*)(g + c), sh = *(const float4*)(md + c), sc = *(const float4*)(md + 1024 + c);
        float o0 = v[u][i].x * rs * gg.x * (1.f + sc.x) + sh.x, o1 = v[u][i].y * rs * gg.y * (1.f + sc.y) + sh.y;
        float o2 = v[u][i].z * rs * gg.z * (1.f + sc.z) + sh.z, o3 = v[u][i].w * rs * gg.w * (1.f + sc.w) + sh.w;
        uint2 o; o.x = pack2(o0, o1); o.y = pack2(o2, o3);
        *(uint2*)(p.Hn + (size_t)rw * DM + c) = o;
      }
    }
  }
}

DI void phase_final_norm(const Params& p) {
  const int w = tid_() >> 6, l = tid_() & 63;
  constexpr int NR = NBATCH * SEQ;
  for (int row = bid_() * 8 + w; row < NR / 2; row += gridDim.x * 8) {
    float4 v[2][4]; float ss[2];
#pragma unroll
    for (int u = 0; u < 2; ++u) {
      const float* xr = p.out + (size_t)(row + u * (NR / 2)) * DM;
      ss[u] = 0;
#pragma unroll
      for (int i = 0; i < 4; ++i) { v[u][i] = *(const float4*)(xr + i * 256 + l * 4); ss[u] += v[u][i].x * v[u][i].x + v[u][i].y * v[u][i].y + v[u][i].z * v[u][i].z + v[u][i].w * v[u][i].w; }
    }
#pragma unroll
    for (int u = 0; u < 2; ++u) {
      float* xr = p.out + (size_t)(row + u * (NR / 2)) * DM;
      const float rs = rsqrtf(wave_sum(ss[u]) * (1.f / DM) + EPSN);
#pragma unroll
      for (int i = 0; i < 4; ++i) {
        const int c = i * 256 + l * 4;
        float4 gg = *(const float4*)(p.final_g + c);
        *(float4*)(xr + c) = make_float4(v[u][i].x * rs * gg.x, v[u][i].y * rs * gg.y, v[u][i].z * rs * gg.z, v[u][i].w * rs * gg.w);
      }
    }
  }
}

template <int MI = 4, class AL, class EP>
DI void gemm_tile(char* smem, const AL& al, const bf16_t* __restrict__ B, int ldb, int N, const EP& ep, int m0, int n0, int K) {
  bf16_t* sA = (bf16_t*)smem;
  bf16_t* sB = sA + 2 * 256 * 72;
  const int tid = tid_(), w = tid >> 6, l = tid & 63, r = l & 31, h = l >> 5;
  const int wm = w >> 2, wn = w & 3;
  const int lrow = tid >> 3, lk = (tid & 7) * 8;
  f32x16 acc[MI][2];
#pragma unroll
  for (int a = 0; a < MI; ++a)
#pragma unroll
    for (int b = 0; b < 2; ++b)
#pragma unroll
      for (int i = 0; i < 16; ++i) acc[a][b][i] = 0.f;
  const bf16_t* Bp0 = B + (size_t)min(n0 + lrow, N - 1) * ldb + lk;
  const bf16_t* Bp1 = B + (size_t)min(n0 + lrow + 64, N - 1) * ldb + lk;
  const bf16_t* Bp2 = B + (size_t)min(n0 + lrow + 128, N - 1) * ldb + lk;
  const bf16_t* Bp3 = B + (size_t)min(n0 + lrow + 192, N - 1) * ldb + lk;
  uint4 xa0, xa1, xa2, xa3, xb0, xb1, xb2, xb3;
  xa1 = xa2 = xa3 = make_uint4(0, 0, 0, 0);
#define GLOADX(kk) \
  xa0 = al(m0 + lrow, (kk) + lk); if (MI > 1) xa1 = al(m0 + lrow + 64, (kk) + lk); if (MI > 2) { xa2 = al(m0 + lrow + 128, (kk) + lk); xa3 = al(m0 + lrow + 192, (kk) + lk); } \
  xb0 = *(const uint4*)(Bp0 + (kk)); xb1 = *(const uint4*)(Bp1 + (kk)); xb2 = *(const uint4*)(Bp2 + (kk)); xb3 = *(const uint4*)(Bp3 + (kk));
#define SSTOREX(bb) \
  *(uint4*)(sA + (bb) * 18432 + (lrow) * 72 + lk) = xa0; if (MI > 1) *(uint4*)(sA + (bb) * 18432 + (lrow + 64) * 72 + lk) = xa1; \
  if (MI > 2) { *(uint4*)(sA + (bb) * 18432 + (lrow + 128) * 72 + lk) = xa2; *(uint4*)(sA + (bb) * 18432 + (lrow + 192) * 72 + lk) = xa3; } \
  *(uint4*)(sB + (bb) * 18432 + (lrow) * 72 + lk) = xb0; *(uint4*)(sB + (bb) * 18432 + (lrow + 64) * 72 + lk) = xb1; \
  *(uint4*)(sB + (bb) * 18432 + (lrow + 128) * 72 + lk) = xb2; *(uint4*)(sB + (bb) * 18432 + (lrow + 192) * 72 + lk) = xb3;
  const int nk = K >> 6;
  GLOADX(0)
  __syncthreads();
  SSTOREX(0)
  GLOADX(min(1, nk - 1) * 64)
  for (int kt = 0; kt < nk; ++kt) {
    const int buf = kt & 1;
    __syncthreads();
    SSTOREX(buf ^ 1)
    __builtin_amdgcn_sched_barrier(0);
    GLOADX(min(kt + 2, nk - 1) * 64)
    __builtin_amdgcn_sched_barrier(0);
    const bf16_t* cA = sA + buf * 18432 + (wm * 32 * MI + r) * 72 + 8 * h;
    const bf16_t* cB = sB + buf * 18432 + (wn * 64 + r) * 72 + 8 * h;
#pragma unroll
    for (int ks = 0; ks < 4; ++ks) {
      bf16x8 b0 = *(const bf16x8*)(cB + ks * 16), b1 = *(const bf16x8*)(cB + 32 * 72 + ks * 16);
#pragma unroll
      for (int a = 0; a < MI; ++a) {
        bf16x8 af = *(const bf16x8*)(cA + a * 32 * 72 + ks * 16);
        acc[a][0] = MFMA32(b0, af, acc[a][0]);
        acc[a][1] = MFMA32(b1, af, acc[a][1]);
      }
    }
  }
#undef GLOADX
#undef SSTOREX
  const int row0 = m0 + wm * 32 * MI + r, cb0 = n0 + wn * 64 + 4 * h;
  if constexpr (std::is_invocable_v<EP, int, int, int, const f32x16&, const f32x16&>) {
#pragma unroll
    for (int a = 0; a < MI; ++a) ep(row0 + 32 * a, n0 + wn * 64, h, acc[a][0], acc[a][1]);
  } else {
#pragma unroll
    for (int a = 0; a < MI; ++a)
#pragma unroll
      for (int g = 0; g < 4; ++g) {
        ep(row0 + 32 * a, cb0 + 8 * g, acc[a][0][4 * g], acc[a][0][4 * g + 1], acc[a][0][4 * g + 2], acc[a][0][4 * g + 3]);
        ep(row0 + 32 * a, cb0 + 32 + 8 * g, acc[a][1][4 * g], acc[a][1][4 * g + 1], acc[a][1][4 * g + 2], acc[a][1][4 * g + 3]);
      }
  }
}


template <int MI = 4, class EP>
DI void gemm_tile_dma(char* smem, const bf16_t* __restrict__ A, int lda, const bf16_t* __restrict__ B, int ldb, int N,
                      const EP& ep, int m0, int n0, int K) {
  constexpr int STAGE = 65536;
  constexpr int MT = 2 * MI;
  const int tid = tid_(), w = tid >> 6, l = tid & 63, r16 = l & 15, q4 = l >> 4;
  const int wm = w >> 2, wn = w & 3;
  f32x4 acc[MT][4];
#pragma unroll
  for (int a = 0; a < MT; ++a)
#pragma unroll
    for (int b = 0; b < 4; ++b) { acc[a][b][0] = 0.f; acc[a][b][1] = 0.f; acc[a][b][2] = 0.f; acc[a][b][3] = 0.f; }
  const int srow = tid >> 3, slog = (tid & 7) ^ ((tid >> 4) & 7);
  const bf16_t* Ag = A + (size_t)(m0 + srow) * lda + slog * 8;
  const bf16_t* Bg0 = B + (size_t)min(n0 + srow, N - 1) * ldb + slog * 8;
  const bf16_t* Bg1 = B + (size_t)min(n0 + srow + 64, N - 1) * ldb + slog * 8;
  const bf16_t* Bg2 = B + (size_t)min(n0 + srow + 128, N - 1) * ldb + slog * 8;
  const bf16_t* Bg3 = B + (size_t)min(n0 + srow + 192, N - 1) * ldb + slog * 8;
  char* wbase = smem + w * 1024;
#define DMA16(g, lds) __builtin_amdgcn_global_load_lds((const unsigned*)(g), (unsigned*)(lds), 16, 0, 0)
#define STAGE_TILE(bb, kk) { char* sb_ = wbase + (bb) * STAGE; \
    DMA16(Ag + (kk), sb_); \
    if (MI > 1) DMA16(Ag + (size_t)64 * lda + (kk), sb_ + 8192); \
    if (MI > 2) { DMA16(Ag + (size_t)128 * lda + (kk), sb_ + 16384); DMA16(Ag + (size_t)192 * lda + (kk), sb_ + 24576); } \
    DMA16(Bg0 + (kk), sb_ + 32768); DMA16(Bg1 + (kk), sb_ + 32768 + 8192); \
    DMA16(Bg2 + (kk), sb_ + 32768 + 16384); DMA16(Bg3 + (kk), sb_ + 32768 + 24576); }
  const int nk = K >> 6;
  __syncthreads();
  STAGE_TILE(0, 0)
  asm volatile("s_waitcnt vmcnt(0)" ::: "memory");
  __syncthreads();
  const int swz = r16 >> 1;
  for (int kt = 0; kt < nk; ++kt) {
    const int buf = kt & 1;
    const char* cA = smem + buf * STAGE + (wm * 32 * MI + r16) * 128;
    const char* cB = smem + buf * STAGE + 32768 + (wn * 64 + r16) * 128;
#pragma unroll
    for (int k2 = 0; k2 < 2; ++k2) {
      if (k2 == 1 && kt + 1 < nk) STAGE_TILE(buf ^ 1, (kt + 1) * 64)
      const int po = ((4 * k2 + q4) ^ swz) * 16;
      bf16x8 bf[4];
#pragma unroll
      for (int nt = 0; nt < 4; ++nt) bf[nt] = *(const bf16x8*)(cB + nt * 16 * 128 + po);
      bf16x8 afc = *(const bf16x8*)(cA + po);
#pragma unroll
      for (int a = 0; a < MT; ++a) {
        bf16x8 afn = afc;
        if (a + 1 < MT) afn = *(const bf16x8*)(cA + (a + 1) * 16 * 128 + po);
        __builtin_amdgcn_sched_barrier(0);
#pragma unroll
        for (int nt = 0; nt < 4; ++nt) acc[a][nt] = MFMA16(bf[nt], afc, acc[a][nt]);
        __builtin_amdgcn_sched_barrier(0);
        afc = afn;
      }
    }
    asm volatile("s_waitcnt vmcnt(0)" ::: "memory");
    __syncthreads();
  }
#undef DMA16
#undef STAGE_TILE
  const int row0 = m0 + wm * 32 * MI + r16, cbw = n0 + wn * 64;
  if constexpr (std::is_invocable_v<EP, int, int, int, const f32x4&, const f32x4&, const f32x4&, const f32x4&>) {
#pragma unroll
    for (int a = 0; a < MT; ++a) ep(row0 + 16 * a, cbw, q4, acc[a][0], acc[a][1], acc[a][2], acc[a][3]);
  } else {
#pragma unroll
    for (int a = 0; a < MT; ++a)
#pragma unroll
      for (int nt = 0; nt < 4; ++nt)
        ep(row0 + 16 * a, cbw + 16 * nt + 4 * q4, acc[a][nt][0], acc[a][nt][1], acc[a][nt][2], acc[a][nt][3]);
  }
}

DI void row_rms(float* rs, const bf16_t* __restrict__ A, int lda, int m0, int K) {
  const int row = tid_() >> 1, hf = tid_() & 1;
  const bf16_t* a = A + (size_t)(m0 + row) * lda + hf * (K >> 1);
  float ss = 0;
  for (int k = 0; k < (K >> 1); k += 8) {
    uint4 v = *(const uint4*)(a + k);
    float lo, hi;
    lo = __uint_as_float(v.x << 16); hi = __uint_as_float(v.x & 0xffff0000u); ss += lo * lo + hi * hi;
    lo = __uint_as_float(v.y << 16); hi = __uint_as_float(v.y & 0xffff0000u); ss += lo * lo + hi * hi;
    lo = __uint_as_float(v.z << 16); hi = __uint_as_float(v.z & 0xffff0000u); ss += lo * lo + hi * hi;
    lo = __uint_as_float(v.w << 16); hi = __uint_as_float(v.w & 0xffff0000u); ss += lo * lo + hi * hi;
  }
  ss += __shfl_xor(ss, 1, 64);
  __syncthreads();
  if (hf == 0) rs[row] = rsqrtf(ss / (float)K + EPSN);
  __syncthreads();
}

template <int TMI, class F>
DI void for_tiles_xcd(int MT, int NT, const F& f) {
  const int total = MT * NT, G = gridDim.x, nslots = G >> 3;
  const int b = bid_(), x = b & 7, slot = b >> 3;
  const int total_full = (total / G) * G;
  const int full = (MT >> 3) * 8 * NT, gsz = MT - (MT >> 3) * 8;
  auto decode = [&](int L, int& mt, int& nt) {
    if (L < full) { const int mg = L / (8 * NT), rem = L - mg * 8 * NT; mt = mg * 8 + (rem & 7); nt = rem >> 3; }
    else { const int rem = L - full; nt = rem / gsz; mt = (MT >> 3) * 8 + (rem - nt * gsz); }
  };
  if (slot < nslots)
    for (int c = x; c * 32 < total_full; c += 8)
      for (int kk = slot; kk < 32; kk += nslots) {
        const int L = c * 32 + kk;
        if (L >= total_full) break;
        int mt, nt; decode(L, mt, nt);
        f(mt * 256, nt, std::integral_constant<int, 4>{});
      }
  constexpr int PIECES = 4 / TMI;
  const int npieces = (total - total_full) * PIECES;
  for (int q = b; q < npieces; q += G) {
    int mt, nt; decode(total_full + q / PIECES, mt, nt);
    f(mt * 256 + (q % PIECES) * 64 * TMI, nt, std::integral_constant<int, TMI>{});
  }
}

DI void phase_win(char* smem, const Params& p, int layer) {
  const bf16_t* Hn = p.Hn;
  auto al = [=](int row, int k) -> uint4 { return *(const uint4*)(Hn + (size_t)row * DM + k); };
  const float qscale = 0.125f * LOG2E;
  auto ep = [&](int row, int cbw, int q4, const f32x4& c0, const f32x4& c1, const f32x4& c2, const f32x4& c3) {
    if (cbw > 2432) return;
    const int b = row / TT, t = row - b * TT;
    const bool lat = t >= CTXL;
    const int pos = t - CTXL;
    float v[16] = {c0[0], c0[1], c0[2], c0[3], c1[0], c1[1], c1[2], c1[3], c2[0], c2[1], c2[2], c2[3], c3[0], c3[1], c3[2], c3[3]};
    if (cbw >= 640 && cbw < 768) {
      bf16_t* vp = p.VsT + ((size_t)(b * 2 + ((cbw - 640) >> 6)) * 64 + q4 * 16) * TT + t;
#pragma unroll
      for (int i = 0; i < 16; ++i) vp[(size_t)i * TT] = f2bf(v[i]);
      return;
    }
    const bool r16 = cbw >= 256 && cbw < 640, rkr = cbw == 2432;
    if (rkr && q4 >= 2) return;
    if (lat && (r16 || rkr)) {
      const int a = r16 ? (q4 >> 1) : q4;
      const int pa = a ? (pos & 63) : (pos >> 6);
      const float* tab = r16 ? p.ropeS + 2 * (pa * 16 + (q4 & 1) * 8) : p.ropeM + 2 * (pa * 8);
#pragma unroll
      for (int k = 0; k < 4; ++k) {
        const float4 cs = *(const float4*)(tab + 4 * k);
        const float x0 = v[4 * k], x1 = v[4 * k + 1], x2 = v[4 * k + 2], x3 = v[4 * k + 3];
        v[4 * k] = x0 * cs.x - x1 * cs.y; v[4 * k + 1] = x1 * cs.x + x0 * cs.y;
        v[4 * k + 2] = x2 * cs.z - x3 * cs.w; v[4 * k + 3] = x3 * cs.z + x2 * cs.w;
      }
    }
    if (cbw >= 256 && cbw < 512) {
#pragma unroll
      for (int i = 0; i < 16; ++i) v[i] *= qscale;
    }
    const uint4 lo = make_uint4(pack2(v[0], v[1]), pack2(v[2], v[3]), pack2(v[4], v[5]), pack2(v[6], v[7]));
    const uint4 hi = make_uint4(pack2(v[8], v[9]), pack2(v[10], v[11]), pack2(v[12], v[13]), pack2(v[14], v[15]));
    if (rkr) {
#pragma unroll
      for (int hd = 0; hd < 4; ++hd) {
        bf16_t* d = p.Km + ((size_t)(b * 4 + hd) * TT + t) * 96 + 64 + q4 * 16;
        *(uint4*)d = lo; *(uint4*)(d + 8) = hi;
      }
      return;
    }
    bf16_t* d;
    if (cbw < 256) d = p.Pu + (size_t)row * 256 + cbw;
    else if (cbw < 512) d = p.Qs + ((size_t)(b * 4 + ((cbw - 256) >> 6)) * TT + t) * 64;
    else if (cbw < 640) d = p.Ks + ((size_t)(b * 2 + ((cbw - 512) >> 6)) * TT + t) * 64;
    else if (cbw < 2048) d = p.PH + (size_t)row * 1280 + (cbw - 768);
    else d = p.Pm + (size_t)row * 384 + (cbw - 2048);
    d += q4 * 16;
    *(uint4*)d = lo; *(uint4*)(d + 8) = hi;
  };
  const bf16_t* W = p.Wi + (size_t)layer * NINP * DM;
  for_tiles_xcd<1>(R / 256, 10, [&](int m0, int nt, auto mi) { gemm_tile_dma<decltype(mi)::value>(smem, Hn, DM, W, DM, NINP, ep, m0, nt * 256, DM); });
}

DI int hg_tok(int dirn, int j) { return dirn == 0 ? j : (j < CTXL ? CTXL - 1 - j : TT + CTXL - 1 - j); }

template <bool FULL>
DI void hg_item(char* smem, const Params& p, int layer, int item) {
  bf16_t* qd = (bf16_t*)(smem + (tid_() >> 8) * 36864);
  bf16_t* ki = qd + 32 * 72;
  bf16_t* keT = ki + 32 * 72;
  bf16_t* vT = keT + 64 * 40;
  bf16_t* att = vT + 64 * 40;
  bf16_t* ST = att + 32 * 40;
  float* tot = (float*)(ST + 64 * 72);
  float* decs = tot + 256;
  const int tid = tid_() & 255, half = tid_() >> 8, w = tid >> 6, l = tid & 63, r16 = l & 15, q4 = l >> 4;
  item = item * 2 + half;
  const int sc = item % NSC, chain = item / NSC;
  const int dirn = chain & 1, head = (chain >> 1) & 3, b = chain >> 3;
  const int d = l, tq = w;
  __syncthreads();
  const float lbv = p.lb[(dirn * 4 + layer) * 256 + head * 64 + d];
  bf16_t* Odir = dirn ? p.OB : p.OF;
  float* Est = p.Eh + (size_t)item * 4096;
  f32x4 sacc[4];
#pragma unroll
  for (int di = 0; di < 4; ++di)
#pragma unroll
    for (int jj = 0; jj < 4; ++jj) {
      if (FULL) {
        const int v = w * 16 + q4 * 4 + jj, dd = di * 16 + r16;
        const float s0 = Est[v * 64 + dd];
        sacc[di][jj] = s0;
        ST[v * 72 + dd] = f2bf(s0);
      } else sacc[di][jj] = 0.f;
    }
  float dprod = 1.f;
  __syncthreads();
  bf16_t pz[4][8], pq[4][8], pv[4][8];
#pragma unroll
  for (int sub = 0; sub < 4; ++sub)
#pragma unroll
    for (int ii = 0; ii < 8; ++ii) {
      const int t = hg_tok(dirn, sc * 128 + sub * 32 + tq * 8 + ii);
      const bf16_t* ph = p.PH + ((size_t)b * TT + t) * 1280 + head * 64 + d;
      pz[sub][ii] = ph[dirn ? 512 : 256];
      if (FULL) pq[sub][ii] = ph[0];
      pv[sub][ii] = ph[768];
    }
#pragma unroll
  for (int sub = 0; sub < 4; ++sub) {
    const int j0 = sc * 128 + sub * 32;
    float cum[8], kk[8], qv[8], vv[8];
    float csum = 0;
#pragma unroll
    for (int ii = 0; ii < 8; ++ii) {
      const float z = bf2f(pz[sub][ii]);
      qv[ii] = FULL ? bf2f(pq[sub][ii]) : 0.f; vv[ii] = bf2f(pv[sub][ii]);
      const float sg = __builtin_amdgcn_rcpf(1.f + __expf(-z)), sgn = __builtin_amdgcn_rcpf(1.f + __expf(z));
      const float f = lbv + (1.f - lbv) * sg;
      kk[ii] = (1.f - lbv) * sgn;
      csum += __logf(f);
      cum[ii] = csum;
    }
    tot[tq * 64 + d] = csum;
    __syncthreads();
    float off = 0, last = 0;
#pragma unroll
    for (int q = 0; q < 4; ++q) { const float tv = tot[q * 64 + d]; last += tv; if (q < tq) off += tv; }
#pragma unroll
    for (int ii = 0; ii < 8; ++ii) {
      const int i = tq * 8 + ii;
      const float cu = off + cum[ii];
      if (FULL) { qd[i * 72 + d] = f2bf(qv[ii] * __expf(cu)); ki[i * 72 + d] = f2bf(kk[ii] * __expf(-cu)); }
      keT[d * 40 + i] = f2bf(kk[ii] * __expf(last - cu));
      vT[d * 40 + i] = f2bf(vv[ii]);
    }
    const float dl = __expf(last);
    if (tq == 0) { decs[d] = dl; dprod *= dl; }
    __syncthreads();
    if (FULL) {
      const int ti = w >> 1, si = w & 1;
      f32x4 acc = {0.f, 0.f, 0.f, 0.f};
#pragma unroll
      for (int ks = 0; ks < 2; ++ks) {
        bf16x8 a = *(const bf16x8*)(qd + (ti * 16 + r16) * 72 + ks * 32 + q4 * 8);
        bf16x8 bb = *(const bf16x8*)(ki + (si * 16 + r16) * 72 + ks * 32 + q4 * 8);
        acc = MFMA16(a, bb, acc);
      }
#pragma unroll
      for (int jj = 0; jj < 4; ++jj) {
        const int t = ti * 16 + q4 * 4 + jj, s = si * 16 + r16;
        att[t * 40 + s] = f2bf(s <= t ? acc[jj] : 0.f);
      }
      __syncthreads();
#pragma unroll
      for (int ti2 = 0; ti2 < 2; ++ti2) {
        f32x4 oacc = {0.f, 0.f, 0.f, 0.f};
        {
          bf16x8 a = *(const bf16x8*)(att + (ti2 * 16 + r16) * 40 + q4 * 8);
          bf16x8 bb = *(const bf16x8*)(vT + (w * 16 + r16) * 40 + q4 * 8);
          oacc = MFMA16(a, bb, oacc);
        }
#pragma unroll
        for (int ks = 0; ks < 2; ++ks) {
          bf16x8 a = *(const bf16x8*)(qd + (ti2 * 16 + r16) * 72 + ks * 32 + q4 * 8);
          bf16x8 bb = *(const bf16x8*)(ST + (w * 16 + r16) * 72 + ks * 32 + q4 * 8);
          oacc = MFMA16(a, bb, oacc);
        }
#pragma unroll
        for (int jj = 0; jj < 4; ++jj) {
          const int i = ti2 * 16 + q4 * 4 + jj;
          const int t = hg_tok(dirn, j0 + i);
          Odir[((size_t)b * TT + t) * 256 + head * 64 + w * 16 + r16] = f2bf(oacc[jj]);
        }
      }
    }
#pragma unroll
    for (int di = 0; di < 4; ++di) {
      bf16x8 a = *(const bf16x8*)(vT + (w * 16 + r16) * 40 + q4 * 8);
      bf16x8 bb = *(const bf16x8*)(keT + (di * 16 + r16) * 40 + q4 * 8);
      const float dc = decs[di * 16 + r16];
      f32x4 sv = sacc[di];
      sv[0] *= dc; sv[1] *= dc; sv[2] *= dc; sv[3] *= dc;
      sacc[di] = MFMA16(a, bb, sv);
    }
    if (FULL) {
      __syncthreads();
#pragma unroll
      for (int di = 0; di < 4; ++di)
#pragma unroll
        for (int jj = 0; jj < 4; ++jj) ST[(w * 16 + q4 * 4 + jj) * 72 + di * 16 + r16] = f2bf(sacc[di][jj]);
    }
  }
  if (!FULL) {
#pragma unroll
    for (int di = 0; di < 4; ++di)
#pragma unroll
      for (int jj = 0; jj < 4; ++jj) Est[(w * 16 + q4 * 4 + jj) * 64 + di * 16 + r16] = sacc[di][jj];
    if (tq == 0) p.dech[(size_t)item * 64 + d] = dprod;
  }
  __syncthreads();
}

DI void phase_B(char* smem, const Params& p, int layer) {
  float* rs = (float*)(smem + 147456);
  const int J_E = 16 * 5, J_Q = 132 * 2, J_KV = 132 * 2, J_HG2 = NBATCH * 4 * 2 * NSC / 2;
  const float mscale = 0.10206207261596575f * LOG2E;
  const int G = gridDim.x;
  for (int j = bid_(); j < J_HG2; j += G) hg_item<false>(smem, p, layer, j);
  for (int j = (bid_() + G - (J_HG2 % G)) % G; j < J_E; j += G) {
    const int g = j / 5, mt = j % 5;
    const bf16_t* Pu = p.Pu;
    auto al = [=](int row, int k) -> uint4 {
      row = min(row, NCHR - 1);
      return *(const uint4*)(Pu + ((size_t)row * 32 + (k >> 4)) * 256 + g * 16 + (k & 15));
    };
    float* Es5 = p.Es5;
    auto ep = [=](int row, int col, float v0, float v1, float v2, float v3) { if (row < NCHR) *(float4*)(Es5 + ((size_t)row * 16 + g) * 256 + col) = make_float4(v0, v1, v2, v3); };
    gemm_tile(smem, al, p.W1 + (size_t)(layer * 16 + g) * 256 * 512, 512, 256, ep, mt * 256, 0, 512);
  }
  for (int j = (bid_() + G - ((J_HG2 + J_E) % G)) % G; j < J_Q; j += G) {
    const int mt = j >> 1, nt = j & 1;
    row_rms(rs, p.Pm, 384, mt * 256, 256);
    const bf16_t* Pm = p.Pm;
    auto al = [=](int row, int k) -> uint4 { return *(const uint4*)(Pm + (size_t)row * 384 + k); };
    const float* ropeM = p.ropeM; bf16_t* Qm = p.Qm;
    auto ep = [=](int row, int col, float v0, float v1, float v2, float v3) {
      if (col >= 384) return;
      const int b = row / TT, t = row - b * TT;
      const int hd = col / 96, dd = col - hd * 96;
      const float rr = rs[row - mt * 256] * mscale;
      v0 *= rr; v1 *= rr; v2 *= rr; v3 *= rr;
      if (dd >= 64 && t >= CTXL) {
        const int e = dd - 64, pos = t - CTXL;
        const int a = e >> 4, f = (e & 15) >> 1;
        const int pa = a ? (pos & 63) : (pos >> 6);
        const float4 cs = *(const float4*)(ropeM + 2 * (pa * 8 + f));
        const float o0 = v0 * cs.x - v1 * cs.y, o1 = v1 * cs.x + v0 * cs.y;
        const float o2 = v2 * cs.z - v3 * cs.w, o3 = v3 * cs.z + v2 * cs.w;
        v0 = o0; v1 = o1; v2 = o2; v3 = o3;
      }
      *(uint2*)(Qm + ((size_t)(b * 4 + hd) * TT + t) * 96 + dd) = make_uint2(pack2(v0, v1), pack2(v2, v3));
    };
    gemm_tile_dma<4>(smem, p.Pm, 384, p.Wq + (size_t)layer * 384 * 256, 256, 384, ep, mt * 256, nt * 256, 256);
  }
  for (int j = (bid_() + G - ((J_HG2 + J_E + J_Q) % G)) % G; j < J_KV; j += G) {
    const int mt = j >> 1, nt = j & 1;
    row_rms(rs, p.Pm + 256, 384, mt * 256, 128);
    const bf16_t* Pm = p.Pm + 256;
    auto al = [=](int row, int k) -> uint4 { return *(const uint4*)(Pm + (size_t)row * 384 + k); };
    bf16_t* Km = p.Km; bf16_t* VmT = p.VmT;
    auto ep = [=](int row, int col, float v0, float v1, float v2, float v3) {
      const int b = row / TT, t = row - b * TT;
      const int hd = col >> 7, jj = col & 127;
      const float rr = rs[row - mt * 256];
      v0 *= rr; v1 *= rr; v2 *= rr; v3 *= rr;
      if (jj < 64) *(uint2*)(Km + ((size_t)(b * 4 + hd) * TT + t) * 96 + jj) = make_uint2(pack2(v0, v1), pack2(v2, v3));
      else {
        bf16_t* vp = VmT + ((size_t)(b * 4 + hd) * 64 + (jj - 64)) * TT + t;
        vp[0] = f2bf(v0); vp[TT] = f2bf(v1); vp[2 * TT] = f2bf(v2); vp[3 * TT] = f2bf(v3);
      }
    };
    gemm_tile_dma<4>(smem, p.Pm + 256, 384, p.Wkv + (size_t)layer * 512 * 128, 128, 512, ep, mt * 256, nt * 256, 128);
  }
}

template <int DQK, bool WINDOW>
DI void attn_item(char* smem, const bf16_t* __restrict__ Q, const bf16_t* __restrict__ K, const bf16_t* __restrict__ VT,
                  int qh, int kvh, int b, int q0, bool has_sink, float sink_l2, bf16_t* __restrict__ Y, int ycol) {
  constexpr int KS = DQK / 16, KSTR = DQK + 8, VSTR = 72, KV8 = DQK / 8;
  bf16_t* sK = (bf16_t*)smem;
  bf16_t* sV = sK + 64 * KSTR;
  const int tid = tid_(), w = tid >> 6, l = tid & 63, r = l & 31, h = l >> 5;
  bf16x8 qf[KS];
  {
    const bf16_t* qp = Q + ((size_t)qh * TT + q0 + w * 32 + r) * DQK + 8 * h;
#pragma unroll
    for (int ks = 0; ks < KS; ++ks) qf[ks] = *(const bf16x8*)(qp + ks * 16);
  }
  f32x16 o0, o1;
#pragma unroll
  for (int i = 0; i < 16; ++i) { o0[i] = 0; o1[i] = 0; }
  float m = 0.f, lsum = 0.f;
  int lo, hi;
  if (q0 < CTXL) { lo = CTXL; hi = CTXL; }
  else if (WINDOW) { lo = max(CTXL, q0 - 128); hi = min(TT, q0 + 256 + 128); }
  else { lo = CTXL; hi = TT; }
  const int ntiles = 4 + ((hi - lo) >> 6);
  const bf16_t* Kb = K + (size_t)kvh * TT * DQK;
  const bf16_t* Vb = VT + (size_t)kvh * 64 * TT;
  const int qpos = q0 + w * 32 + r;
  constexpr bool K2 = (64 * KV8) > NTHR;
  constexpr int BUFE = 64 * KSTR + 64 * VSTR;
  uint4 kr0, kr1, vr0;
  kr1 = make_uint4(0, 0, 0, 0);
  const int kidx1 = K2 ? min(tid + NTHR, 64 * KV8 - 1) : 0;
  const int krow0 = tid / KV8, kcc0 = tid - krow0 * KV8, krow1 = kidx1 / KV8, kcc1 = kidx1 - krow1 * KV8;
  const int vrow0 = tid >> 3, vcc0 = tid & 7;
#define TILE_K0(i) ((i) < 4 ? (i) * 64 : lo + ((i) - 4) * 64)
#define ALOAD(i) { const int kk0 = TILE_K0(i); \
    kr0 = *(const uint4*)(Kb + (size_t)(kk0 + krow0) * DQK + kcc0 * 8); \
    if (K2) kr1 = *(const uint4*)(Kb + (size_t)(kk0 + krow1) * DQK + kcc1 * 8); \
    vr0 = *(const uint4*)(Vb + (size_t)vrow0 * TT + kk0 + vcc0 * 8); }
#define ASTORE(bb) { bf16_t* dK = (bf16_t*)smem + (bb) * BUFE; bf16_t* dV = dK + 64 * KSTR; \
    *(uint4*)(dK + krow0 * KSTR + kcc0 * 8) = kr0; \
    if (K2) *(uint4*)(dK + krow1 * KSTR + kcc1 * 8) = kr1; \
    *(uint4*)(dV + vrow0 * VSTR + vcc0 * 8) = vr0; }
  ALOAD(0)
  __syncthreads();
  ASTORE(0)
  ALOAD(min(1, ntiles - 1))
  for (int it = 0; it < ntiles; ++it) {
    const int k0 = TILE_K0(it);
    __syncthreads();
    ASTORE((it + 1) & 1)
    __builtin_amdgcn_sched_barrier(0);
    ALOAD(min(it + 2, ntiles - 1))
    __builtin_amdgcn_sched_barrier(0);
    sK = (bf16_t*)smem + (it & 1) * BUFE;
    sV = sK + 64 * KSTR;
    f32x16 s0, s1;
    const float ninit = -m;
#pragma unroll
    for (int i = 0; i < 16; ++i) { s0[i] = ninit; s1[i] = ninit; }
#pragma unroll
    for (int ks = 0; ks < KS; ++ks) {
      bf16x8 a0 = *(const bf16x8*)(sK + r * KSTR + ks * 16 + 8 * h);
      bf16x8 a1 = *(const bf16x8*)(sK + (32 + r) * KSTR + ks * 16 + 8 * h);
      s0 = MFMA32(a0, qf[ks], s0);
      s1 = MFMA32(a1, qf[ks], s1);
    }
    if (WINDOW && k0 >= CTXL) {
#pragma unroll
      for (int i = 0; i < 16; ++i) {
        const int kp = k0 + crow(i, h);
        if (abs(qpos - kp) > 128) s0[i] = -1e30f;
        if (abs(qpos - kp - 32) > 128) s1[i] = -1e30f;
      }
    }
    int mxb = max(__float_as_int(s0[0]), __float_as_int(s1[0]));
#pragma unroll
    for (int i = 1; i < 16; ++i) mxb = max(mxb, max(__float_as_int(s0[i]), __float_as_int(s1[i])));
    if (__any((it == 0) || (mxb > 0x41000000))) {
      float mx = -1e30f;
#pragma unroll
      for (int i = 0; i < 16; ++i) mx = fmaxf(mx, fmaxf(s0[i], s1[i]));
      mx = fmaxf(mx, __shfl_xor(mx, 32, 64));
      const float delta = (it == 0) ? mx : fmaxf(mx, 0.f);
      const float alpha = (it == 0) ? 1.f : __builtin_amdgcn_exp2f(-delta);
      m += delta;
      lsum *= alpha;
#pragma unroll
      for (int i = 0; i < 16; ++i) { o0[i] *= alpha; o1[i] *= alpha; s0[i] -= delta; s1[i] -= delta; }
    }
    float rsum = 0;
#pragma unroll
    for (int i = 0; i < 16; ++i) { s0[i] = __builtin_amdgcn_exp2f(s0[i]); s1[i] = __builtin_amdgcn_exp2f(s1[i]); rsum += s0[i] + s1[i]; }
    rsum += __shfl_xor(rsum, 32, 64);
    lsum += rsum;
#pragma unroll
    for (int mt = 0; mt < 2; ++mt) {
#pragma unroll
      for (int s = 0; s < 2; ++s) {
        union { bf16x8 v; unsigned u[4]; } pk;
        if (mt == 0) {
          pk.u[0] = pack2(s0[8 * s + 0], s0[8 * s + 1]); pk.u[1] = pack2(s0[8 * s + 2], s0[8 * s + 3]);
          pk.u[2] = pack2(s0[8 * s + 4], s0[8 * s + 5]); pk.u[3] = pack2(s0[8 * s + 6], s0[8 * s + 7]);
        } else {
          pk.u[0] = pack2(s1[8 * s + 0], s1[8 * s + 1]); pk.u[1] = pack2(s1[8 * s + 2], s1[8 * s + 3]);
          pk.u[2] = pack2(s1[8 * s + 4], s1[8 * s + 5]); pk.u[3] = pack2(s1[8 * s + 6], s1[8 * s + 7]);
        }
        const int base = mt * 32 + s * 16 + 4 * h;
        union { bf16x8 v; uint2 u[2]; } va, vb;
        va.u[0] = *(const uint2*)(sV + r * VSTR + base);
        va.u[1] = *(const uint2*)(sV + r * VSTR + base + 8);
        vb.u[0] = *(const uint2*)(sV + (32 + r) * VSTR + base);
        vb.u[1] = *(const uint2*)(sV + (32 + r) * VSTR + base + 8);
        o0 = MFMA32(va.v, pk.v, o0);
        o1 = MFMA32(vb.v, pk.v, o1);
      }
    }
  }
#undef TILE_K0
#undef ALOAD
#undef ASTORE
  float lt = lsum;
  if (has_sink) lt += __builtin_amdgcn_exp2f(sink_l2 - m);
  const float inv = 1.f / lt;
  bf16_t* yp = Y + ((size_t)b * TT + qpos) * DM + ycol;
#pragma unroll
  for (int g = 0; g < 4; ++g) {
    uint2 u0, u1;
    u0.x = pack2(o0[4 * g] * inv, o0[4 * g + 1] * inv); u0.y = pack2(o0[4 * g + 2] * inv, o0[4 * g + 3] * inv);
    u1.x = pack2(o1[4 * g] * inv, o1[4 * g + 1] * inv); u1.y = pack2(o1[4 * g + 2] * inv, o1[4 * g + 3] * inv);
    *(uint2*)(yp + 8 * g + 4 * h) = u0;
    *(uint2*)(yp + 32 + 8 * g + 4 * h) = u1;
  }
}

template <int DQK>
DI void attn_item2(char* smem, const bf16_t* __restrict__ Q, const bf16_t* __restrict__ K, const bf16_t* __restrict__ VT,
                   int qh, int kvh, int b, int q0, bf16_t* __restrict__ Y, int ycol) {
  constexpr int KS = DQK / 16, KSTR = DQK + 8, VSTR = 72, KV8 = DQK / 8;
  const int tid = tid_(), w = tid >> 6, l = tid & 63, r = l & 31, h = l >> 5;
  bf16x8 qf[2][KS];
#pragma unroll
  for (int qn = 0; qn < 2; ++qn) {
    const bf16_t* qp = Q + ((size_t)qh * TT + q0 + w * 64 + qn * 32 + r) * DQK + 8 * h;
#pragma unroll
    for (int ks = 0; ks < KS; ++ks) qf[qn][ks] = *(const bf16x8*)(qp + ks * 16);
  }
  f32x16 o[2][2];
#pragma unroll
  for (int qn = 0; qn < 2; ++qn)
#pragma unroll
    for (int i = 0; i < 16; ++i) { o[qn][0][i] = 0; o[qn][1][i] = 0; }
  float m[2] = {0.f, 0.f}, lsum[2] = {0.f, 0.f};
  const int ntiles = TT / 64;
  const bf16_t* Kb = K + (size_t)kvh * TT * DQK;
  const bf16_t* Vb = VT + (size_t)kvh * 64 * TT;
  constexpr bool K2 = (64 * KV8) > NTHR;
  constexpr int BUFE = 64 * KSTR + 64 * VSTR;
  uint4 kr0, kr1, vr0;
  kr1 = make_uint4(0, 0, 0, 0);
  const int kidx1 = K2 ? min(tid + NTHR, 64 * KV8 - 1) : 0;
  const int krow0 = tid / KV8, kcc0 = tid - krow0 * KV8, krow1 = kidx1 / KV8, kcc1 = kidx1 - krow1 * KV8;
  const int vrow0 = tid >> 3, vcc0 = tid & 7;
#define ALOAD(i) { const int kk0 = (i) * 64; \
    kr0 = *(const uint4*)(Kb + (size_t)(kk0 + krow0) * DQK + kcc0 * 8); \
    if (K2) kr1 = *(const uint4*)(Kb + (size_t)(kk0 + krow1) * DQK + kcc1 * 8); \
    vr0 = *(const uint4*)(Vb + (size_t)vrow0 * TT + kk0 + vcc0 * 8); }
#define ASTORE(bb) { bf16_t* dK = (bf16_t*)smem + (bb) * BUFE; bf16_t* dV = dK + 64 * KSTR; \
    *(uint4*)(dK + krow0 * KSTR + kcc0 * 8) = kr0; \
    if (K2) *(uint4*)(dK + krow1 * KSTR + kcc1 * 8) = kr1; \
    *(uint4*)(dV + vrow0 * VSTR + vcc0 * 8) = vr0; }
  ALOAD(0)
  __syncthreads();
  ASTORE(0)
  ALOAD(1)
  for (int it = 0; it < ntiles; ++it) {
    __syncthreads();
    ASTORE((it + 1) & 1)
    __builtin_amdgcn_sched_barrier(0);
    ALOAD(min(it + 2, ntiles - 1))
    __builtin_amdgcn_sched_barrier(0);
    const bf16_t* sK = (const bf16_t*)smem + (it & 1) * BUFE;
    const bf16_t* sV = sK + 64 * KSTR;
    f32x16 s[2][2];
#pragma unroll
    for (int qn = 0; qn < 2; ++qn) {
      const float ninit = -m[qn];
#pragma unroll
      for (int i = 0; i < 16; ++i) { s[qn][0][i] = ninit; s[qn][1][i] = ninit; }
    }
#pragma unroll
    for (int ks = 0; ks < KS; ++ks) {
      bf16x8 a0 = *(const bf16x8*)(sK + r * KSTR + ks * 16 + 8 * h);
      bf16x8 a1 = *(const bf16x8*)(sK + (32 + r) * KSTR + ks * 16 + 8 * h);
#pragma unroll
      for (int qn = 0; qn < 2; ++qn) {
        s[qn][0] = MFMA32(a0, qf[qn][ks], s[qn][0]);
        s[qn][1] = MFMA32(a1, qf[qn][ks], s[qn][1]);
      }
    }
    int mxb = __float_as_int(s[0][0][0]);
#pragma unroll
    for (int qn = 0; qn < 2; ++qn)
#pragma unroll
      for (int i = 0; i < 16; ++i) mxb = max(mxb, max(__float_as_int(s[qn][0][i]), __float_as_int(s[qn][1][i])));
    if (__any((it == 0) || (mxb > 0x41000000))) {
#pragma unroll
      for (int qn = 0; qn < 2; ++qn) {
        float mx = -1e30f;
#pragma unroll
        for (int i = 0; i < 16; ++i) mx = fmaxf(mx, fmaxf(s[qn][0][i], s[qn][1][i]));
        mx = fmaxf(mx, __shfl_xor(mx, 32, 64));
        const float delta = (it == 0) ? mx : fmaxf(mx, 0.f);
        const float alpha = (it == 0) ? 1.f : __builtin_amdgcn_exp2f(-delta);
        m[qn] += delta;
        lsum[qn] *= alpha;
#pragma unroll
        for (int i = 0; i < 16; ++i) { o[qn][0][i] *= alpha; o[qn][1][i] *= alpha; s[qn][0][i] -= delta; s[qn][1][i] -= delta; }
      }
    }
#pragma unroll
    for (int mt = 0; mt < 2; ++mt) {
#pragma unroll
      for (int qn = 0; qn < 2; ++qn) {
        float rsum = 0;
#pragma unroll
        for (int i = 0; i < 16; ++i) { s[qn][mt][i] = __builtin_amdgcn_exp2f(s[qn][mt][i]); rsum += s[qn][mt][i]; }
        lsum[qn] += rsum;
      }
#pragma unroll
      for (int sx = 0; sx < 2; ++sx) {
        const int base = mt * 32 + sx * 16 + 4 * h;
        union { bf16x8 v; uint2 u[2]; } va, vb;
        va.u[0] = *(const uint2*)(sV + r * VSTR + base);
        va.u[1] = *(const uint2*)(sV + r * VSTR + base + 8);
        vb.u[0] = *(const uint2*)(sV + (32 + r) * VSTR + base);
        vb.u[1] = *(const uint2*)(sV + (32 + r) * VSTR + base + 8);
#pragma unroll
        for (int qn = 0; qn < 2; ++qn) {
          union { bf16x8 v; unsigned u[4]; } pk;
          pk.u[0] = pack2(s[qn][mt][8 * sx + 0], s[qn][mt][8 * sx + 1]); pk.u[1] = pack2(s[qn][mt][8 * sx + 2], s[qn][mt][8 * sx + 3]);
          pk.u[2] = pack2(s[qn][mt][8 * sx + 4], s[qn][mt][8 * sx + 5]); pk.u[3] = pack2(s[qn][mt][8 * sx + 6], s[qn][mt][8 * sx + 7]);
          o[qn][0] = MFMA32(va.v, pk.v, o[qn][0]);
          o[qn][1] = MFMA32(vb.v, pk.v, o[qn][1]);
        }
      }
    }
  }
#undef ALOAD
#undef ASTORE
#pragma unroll
  for (int qn = 0; qn < 2; ++qn) {
    const float lt = lsum[qn] + __shfl_xor(lsum[qn], 32, 64);
    const float inv = 1.f / lt;
    bf16_t* yp = Y + ((size_t)b * TT + q0 + w * 64 + qn * 32 + r) * DM + ycol;
#pragma unroll
    for (int g = 0; g < 4; ++g) {
      uint2 u0, u1;
      u0.x = pack2(o[qn][0][4 * g] * inv, o[qn][0][4 * g + 1] * inv); u0.y = pack2(o[qn][0][4 * g + 2] * inv, o[qn][0][4 * g + 3] * inv);
      u1.x = pack2(o[qn][1][4 * g] * inv, o[qn][1][4 * g + 1] * inv); u1.y = pack2(o[qn][1][4 * g + 2] * inv, o[qn][1][4 * g + 3] * inv);
      *(uint2*)(yp + 8 * g + 4 * h) = u0;
      *(uint2*)(yp + 32 + 8 * g + 4 * h) = u1;
    }
  }
}

DI void phase_C(char* smem, const Params& p, int layer) {
  const int J_S5 = 16, J_HG = 256, J_SWA = NBATCH * 4 * 33;
  const int G = gridDim.x;
  for (int j = bid_(); j < J_S5; j += G) {
    const int gid = j * NTHR + tid_();
    const int pp = gid & 63, dirn = (gid >> 6) & 1, g = (gid >> 7) & 15, b = gid >> 11;
    const int jb = (layer * 2 + dirn) * 16 + g;
    const float ar = p.apow[((size_t)jb * 33 + 32) * 128 + pp * 2], ai = p.apow[((size_t)jb * 33 + 32) * 128 + pp * 2 + 1];
    float sr = 0, si = 0;
    float* base = p.Es5 + ((size_t)b * NCH * 16 + g) * 256 + dirn * 128 + pp * 2;
#define MCH(n) (dirn == 0 ? (n) : ((n) < 8 ? 7 - (n) : 271 - (n)))
#pragma unroll 1
    for (int n0 = 0; n0 < NCH; n0 += 44) {
      float2 e[44];
#pragma unroll
      for (int u = 0; u < 44; ++u) e[u] = *(const float2*)(base + (size_t)MCH(n0 + u) * 4096);
#pragma unroll
      for (int u = 0; u < 44; ++u) {
        *(float2*)(base + (size_t)MCH(n0 + u) * 4096) = make_float2(sr, si);
        const float nr = ar * sr - ai * si + e[u].x, ni = ar * si + ai * sr + e[u].y;
        sr = nr; si = ni;
      }
    }
#undef MCH
  }
  for (int j = bid_(); j < J_HG; j += G) {
    const int gid = j * NTHR + tid_();
    const int chain = gid >> 12, e = gid & 4095, d = e & 63;
    float* base = p.Eh + (size_t)chain * NSC * 4096 + e;
    const float* db = p.dech + (size_t)chain * NSC * 64 + d;
    float s = 0;
#pragma unroll 1
    for (int n0 = 0; n0 < NSC; n0 += 22) {
      float ev[22], dv[22];
#pragma unroll
      for (int u = 0; u < 22; ++u) { ev[u] = base[(size_t)(n0 + u) * 4096]; dv[u] = db[(n0 + u) * 64]; }
#pragma unroll
      for (int u = 0; u < 22; ++u) { base[(size_t)(n0 + u) * 4096] = s; s = dv[u] * s + ev[u]; }
    }
  }
  {
    const int nb = G > 32 ? G - 16 : G, me = G > 32 ? bid_() - 16 : bid_();
    if (me >= 0) {
      for (int j = me; j < J_SWA; j += nb) {
        const int qt = j % 33, bh = j / 33, hd = bh & 3, b = bh >> 2;
        attn_item<64, true>(smem, p.Qs, p.Ks, p.VsT, b * 4 + hd, b * 2 + (hd >> 1), b, qt * 256, true,
                            p.sink[layer * 4 + hd] * LOG2E, p.Hn, 256 + hd * 64);
      }
    }
  }
}

DI void phase_D(char* smem, const Params& p, int layer) {
  const int J_MLA = 256 + 16, J_RD = 16 * 5 * 2, J_HG = NBATCH * 4 * 2 * NSC / 2;
  const int G = gridDim.x;
  for (int j = bid_(); j < J_MLA; j += G) {
    if (j < 256) {
      const int rest = j >> 3, bh = (j & 7) + 8 * (rest >> 4), qt = rest & 15;
      attn_item2<96>(smem, p.Qm, p.Km, p.VmT, bh, bh, bh >> 2, CTXL + qt * 512, p.Hn, 768 + (bh & 3) * 64);
    } else {
      const int bh = j - 256;
      attn_item<96, false>(smem, p.Qm, p.Km, p.VmT, bh, bh, bh >> 2, 0, false, 0.f, p.Hn, 768 + (bh & 3) * 64);
    }
  }
  for (int j = (bid_() + G - (J_MLA % G)) % G; j < J_RD; j += G) {
    const int g = j / 10, q = j % 10, mt = q >> 1, nt = q & 1;
    const bf16_t* Pu = p.Pu; const float* Es = p.Es5;
    auto al = [=](int row, int k) -> uint4 {
      row = min(row, NCHR - 1);
      if (k < 512) return *(const uint4*)(Pu + ((size_t)row * 32 + (k >> 4)) * 256 + g * 16 + (k & 15));
      const float* e = Es + ((size_t)row * 16 + g) * 256 + (k - 512);
      float4 a = *(const float4*)e, c = *(const float4*)(e + 4);
      return make_uint4(pack2(a.x, a.y), pack2(a.z, a.w), pack2(c.x, c.y), pack2(c.z, c.w));
    };
    bf16_t* Yg = p.Yg;
    auto ep = [=](int row, int col, float v0, float v1, float v2, float v3) {
      if (row >= NCHR) return;
      const int t = col >> 4, hh = col & 15;
      auto gelu = [](float v) {
        const float u = 0.7978845608028654f * (v + 0.044715f * v * v * v);
        const float th = 1.f - 2.f * __builtin_amdgcn_rcpf(1.f + __expf(2.f * u));
        return 0.5f * v * (1.f + th);
      };
      *(uint2*)(Yg + ((size_t)row * 32 + t) * 256 + g * 16 + hh) = make_uint2(pack2(gelu(v0), gelu(v1)), pack2(gelu(v2), gelu(v3)));
    };
    gemm_tile(smem, al, p.TW + (size_t)(layer * 16 + g) * 512 * 768, 768, 512, ep, mt * 256, nt * 256, 768);
  }
  for (int j = (bid_() + G - ((J_MLA + J_RD) % G)) % G; j < J_HG; j += G) hg_item<true>(smem, p, layer, j);
}

DI void phase_E(char* smem, const Params& p, int layer) {
  const int J_GLU = 132, J_FIN = R / 16;
  const int G = gridDim.x;
  for (int j = bid_(); j < J_GLU; j += G) {
    const int mt = j, nt = 0;
    const bf16_t* Yg = p.Yg; bf16_t* Hn = p.Hn; const float* bg = p.b_glu + layer * 256;
    auto al = [=](int row, int k) -> uint4 { return *(const uint4*)(Yg + (size_t)row * 256 + k); };
    auto ep = [=](int row, int col, float v0, float v1, float v2, float v3) {
      const uint2 yy = *(const uint2*)(Yg + (size_t)row * 256 + col);
      const float4 bb = *(const float4*)(bg + col);
      const float y0 = __uint_as_float(yy.x << 16), y1 = __uint_as_float(yy.x & 0xffff0000u);
      const float y2 = __uint_as_float(yy.y << 16), y3 = __uint_as_float(yy.y & 0xffff0000u);
      *(uint2*)(Hn + (size_t)row * DM + col) = make_uint2(pack2(y0 * fsigmoid(v0 + bb.x), y1 * fsigmoid(v1 + bb.y)),
                                                         pack2(y2 * fsigmoid(v2 + bb.z), y3 * fsigmoid(v3 + bb.w)));
    };
    gemm_tile_dma<4>(smem, p.Yg, 256, p.Wg + (size_t)layer * 65536, 256, 256, ep, mt * 256, nt * 256, 256);
  }
  for (int j = (bid_() + G - (J_GLU % G)) % G; j < J_FIN; j += G) {
    const int w = (tid_() >> 6) & 3, rsel = tid_() >> 8, l = tid_() & 63;
    const float gn = p.hg_norm_g[layer * 64 + l];
#pragma unroll
    for (int rr = 0; rr < 8; ++rr) {
      const int row = j * 16 + rr * 2 + rsel;
      const float o = bf2f(p.OF[(size_t)row * 256 + w * 64 + l]) + bf2f(p.OB[(size_t)row * 256 + w * 64 + l]);
      const float ss = wave_sum(o * o);
      const float rs = rsqrtf(ss * (1.f / 64.f) + EPSN);
      const float gt = bf2f(p.PH[(size_t)row * 1280 + 1024 + w * 64 + l]);
      p.Hn[(size_t)row * DM + 512 + w * 64 + l] = f2bf(o * rs * gn * gt * sigmoidf_(gt));
    }
  }
}

DI void phase_resid(char* smem, const Params& p, int layer, const bf16_t* A, int K, const bf16_t* W, int gate_idx, bool first) {
  auto al = [=](int row, int k) -> uint4 { return *(const uint4*)(A + (size_t)row * K + k); };
  auto ep = [&](int row, int col, float v0, float v1, float v2, float v3) {
    const int b = row / TT, t = row - b * TT;
    const float4 g = *(const float4*)(p.mod + (size_t)(layer * 5 + (t < CTXL ? 4 : b)) * 6144 + gate_idx * 1024 + col);
    const float4 xo = *(const float4*)(xsrc_row(p, first, row) + col);
    *(float4*)(xdst_row(p, row) + col) = make_float4(xo.x + g.x * v0, xo.y + g.y * v1, xo.z + g.z * v2, xo.w + g.w * v3);
  };
  for_tiles_xcd<1>(R / 256, 4, [&](int m0, int nt, auto mi) { gemm_tile_dma<decltype(mi)::value>(smem, A, K, W, K, DM, ep, m0, nt * 256, K); });
}

DI void phase_ffn_up(char* smem, const Params& p, int layer) {
  const bf16_t* Hn = p.Hn;
  auto al = [=](int row, int k) -> uint4 { return *(const uint4*)(Hn + (size_t)row * DM + k); };
  bf16_t* Hh = p.H;
  auto ep = [=](int row, int cb, int q4, const f32x4& c0, const f32x4& c1, const f32x4& c2, const f32x4& c3) {
    const uint4 o = make_uint4(pack2(c0[0] * fsigmoid(c0[0]) * c0[1], c0[2] * fsigmoid(c0[2]) * c0[3]),
                               pack2(c1[0] * fsigmoid(c1[0]) * c1[1], c1[2] * fsigmoid(c1[2]) * c1[3]),
                               pack2(c2[0] * fsigmoid(c2[0]) * c2[1], c2[2] * fsigmoid(c2[2]) * c2[3]),
                               pack2(c3[0] * fsigmoid(c3[0]) * c3[1], c3[2] * fsigmoid(c3[2]) * c3[3]));
    *(uint4*)(Hh + (size_t)row * FH + (cb >> 1) + q4 * 8) = o;
  };
  const bf16_t* W = p.Wu + (size_t)layer * 2 * FH * DM;
  for_tiles_xcd<2>(R / 256, 22, [&](int m0, int nt, auto mi) { gemm_tile_dma<decltype(mi)::value>(smem, Hn, DM, W, DM, 2 * FH, ep, m0, nt * 256, DM); });
}

constexpr int N_PHASES = 2 + 10 * DEPTH;

__global__ void __launch_bounds__(512, 2) mega(Params p, int ph_lo, int ph_hi) {
  extern __shared__ __attribute__((aligned(16))) char smem[];
  for (int ph = ph_lo; ph < ph_hi; ++ph) {
    if (ph == 0) phase_prep(smem, p);
    else if (ph == 1) { phase_s5mats(p); phase_norm(p, 0, 0, true); }
    else {
      const int layer = (ph - 2) / 10, s = (ph - 2) % 10;
      const bool first = layer == 0;
      switch (s) {
        case 0: phase_win(smem, p, layer); break;
        case 1: phase_B(smem, p, layer); break;
        case 2: phase_C(smem, p, layer); break;
        case 3: phase_D(smem, p, layer); break;
        case 4: phase_E(smem, p, layer); break;
        case 5: phase_resid(smem, p, layer, p.Hn, DM, p.Wo + (size_t)layer * DM * DM, 2, first); break;
        case 6: phase_norm(p, layer, 1, false); break;
        case 7: phase_ffn_up(smem, p, layer); break;
        case 8: phase_resid(smem, p, layer, p.H, FH, p.Wd + (size_t)layer * DM * FH, 5, false); break;
        default:
          if (layer + 1 < DEPTH) phase_norm(p, layer + 1, 0, false); else phase_final_norm(p);
          break;
      }
    }
    if (ph + 1 < ph_hi) grid_barrier(p.bar, (unsigned)(ph - ph_lo + 1));
  }
}

extern "C" void kernel_launch(void* const* d_in, const int* in_sizes, int n_in, void* d_out, int out_size, void* d_ws,
                              size_t ws_size, hipStream_t stream) {
  static int grid_blocks = 0;
  if (!grid_blocks) {
    int dev = 0, cus = 0, per_cu = 0;
    hipGetDevice(&dev);
    hipDeviceGetAttribute(&cus, hipDeviceAttributeMultiprocessorCount, dev);
    hipFuncSetAttribute((const void*)mega, hipFuncAttributeMaxDynamicSharedMemorySize, LDS_BYTES);
    hipOccupancyMaxActiveBlocksPerMultiprocessor(&per_cu, (const void*)mega, NTHR, LDS_BYTES);
    (void)per_cu;
    grid_blocks = cus;
  }
  Params p{};
  const float** ins = (const float**)&p;
  for (int i = 0; i < 30; ++i) ins[i] = (const float*)d_in[i];
  p.out = (float*)d_out;
  char* ws = (char*)d_ws;
  size_t off = 0;
  auto take = [&](size_t bytes) { char* q = ws + off; off += (bytes + 255) & ~(size_t)255; return q; };
  p.bar = (unsigned*)take(8192);
  p.Xc = (float*)take((size_t)NBATCH * CTXL * DM * 4);
  p.mod = (float*)take((size_t)DEPTH * 5 * 6144 * 4);
  p.lb = (float*)take(2 * 4 * 256 * 4);
  p.ropeS = (float*)take(128 * 16 * 2 * 4);
  p.ropeM = (float*)take(128 * 8 * 2 * 4);
  p.apow = (float*)take((size_t)J_S5TAB * 33 * 128 * 4);
  p.bbar = (float*)take((size_t)J_S5TAB * 64 * 16 * 2 * 4);
  p.Ktab = (float*)take((size_t)J_S5TAB * 32 * 256 * 4);
  p.Wi = (bf16_t*)take((size_t)DEPTH * NINP * DM * 2);
  p.Wo = (bf16_t*)take((size_t)DEPTH * DM * DM * 2);
  p.Wu = (bf16_t*)take((size_t)DEPTH * 2 * FH * DM * 2);
  p.Wd = (bf16_t*)take((size_t)DEPTH * DM * FH * 2);
  p.Wg = (bf16_t*)take((size_t)DEPTH * 65536 * 2);
  p.Wq = (bf16_t*)take((size_t)DEPTH * 384 * 256 * 2);
  p.Wkv = (bf16_t*)take((size_t)DEPTH * 512 * 128 * 2);
  p.TW = (bf16_t*)take((size_t)DEPTH * 16 * 512 * 768 * 2);
  p.W1 = (bf16_t*)take((size_t)DEPTH * 16 * 256 * 512 * 2);
  p.Hn = (bf16_t*)take((size_t)R * DM * 2);
  const size_t big0 = off;
  p.Pu = (bf16_t*)take((size_t)R * 256 * 2);
  p.PH = (bf16_t*)take((size_t)R * 1280 * 2);
  p.Es5 = (float*)take((size_t)NCHR * 16 * 256 * 4);
  p.Eh = (float*)take((size_t)NBATCH * 4 * 2 * NSC * 4096 * 4);
  p.dech = (float*)take((size_t)NBATCH * 4 * 2 * NSC * 64 * 4);
  p.Qm = (bf16_t*)take((size_t)R * 4 * 96 * 2);
  p.Km = (bf16_t*)take((size_t)R * 4 * 96 * 2);
  p.VmT = (bf16_t*)take((size_t)R * 256 * 2);
  const size_t al0 = off;
  p.Pm = (bf16_t*)take((size_t)R * 384 * 2);
  p.Qs = (bf16_t*)take((size_t)R * 256 * 2);
  p.Ks = (bf16_t*)take((size_t)R * 128 * 2);
  p.VsT = (bf16_t*)take((size_t)R * 128 * 2);
  const size_t end1 = off;
  off = al0;
  p.Yg = (bf16_t*)take((size_t)R * 256 * 2);
  p.OF = (bf16_t*)take((size_t)R * 256 * 2);
  p.OB = (bf16_t*)take((size_t)R * 256 * 2);
  size_t end2 = off;
  p.H = (bf16_t*)(ws + big0);
  size_t endH = big0 + (size_t)R * FH * 2;
  size_t total = end1 > end2 ? end1 : end2;
  if (endH > total) total = endH;
  if (total > ws_size) { fprintf(stderr, "kernel_launch: workspace too small: need %zu, have %zu\n", total, ws_size); return; }
  if (hipMemsetAsync(p.bar, 0, 8192, stream) != hipSuccess) { fprintf(stderr, "memset failed\n"); return; }
  int lo = 0, hi = N_PHASES;
  void* args[] = {&p, &lo, &hi};
  hipError_t e = hipLaunchCooperativeKernel((const void*)mega, dim3(grid_blocks), dim3(NTHR), args, LDS_BYTES, stream);
  if (e != hipSuccess) fprintf(stderr, "cooperative launch failed: %s (grid %d)\n", hipGetErrorString(e), grid_blocks);
}
```

```cpp
#include <hip/hip_runtime.h>
#include <hip/hip_cooperative_groups.h>
#include <cstdio>
#include <type_traits>
namespace cg = cooperative_groups;

#define DI __device__ __forceinline__
typedef unsigned short bf16_t;
using bf16x8 = __attribute__((ext_vector_type(8))) short;
using f32x16 = __attribute__((ext_vector_type(16))) float;
using f32x4  = __attribute__((ext_vector_type(4))) float;

constexpr int DM = 1024, NBATCH = 4, SEQ = 8192, CTXL = 256, TT = SEQ + CTXL, R = NBATCH * TT, DEPTH = 4;
constexpr int NIN = 2464, FH = 2816;
constexpr int NINP = 2496;
constexpr int NCH = TT / 32;
constexpr int NCHR = NBATCH * NCH;
constexpr int NSC = TT / 128;
constexpr float LOG2E = 1.4426950408889634f;
constexpr float EPSN = 1e-6f;
constexpr int NTHR = 512;
constexpr int LDS_BYTES = 147456 + 1024;

#define MFMA32(a, b, c) __builtin_amdgcn_mfma_f32_32x32x16_bf16((a), (b), (c), 0, 0, 0)
#define MFMA16(a, b, c) __builtin_amdgcn_mfma_f32_16x16x32_bf16((a), (b), (c), 0, 0, 0)

DI int tid_() { int t = threadIdx.x; asm volatile("" : "+v"(t)); return t; }
DI int bid_() { int b = blockIdx.x; asm volatile("" : "+s"(b)); return b; }
typedef __bf16 hwbf2_t __attribute__((ext_vector_type(2)));
typedef float hwf2_t __attribute__((ext_vector_type(2)));
DI unsigned pack2(float a, float b) { hwf2_t f = {a, b}; return __builtin_bit_cast(unsigned, __builtin_convertvector(f, hwbf2_t)); }
DI bf16_t f2bf(float x) { return (bf16_t)(pack2(x, 0.f) & 0xffffu); }
DI float bf2f(bf16_t b) { return __uint_as_float(((unsigned)b) << 16); }
DI int crow(int reg, int h) { return (reg & 3) + 8 * (reg >> 2) + 4 * h; }
DI float sigmoidf_(float x) { return 1.f / (1.f + expf(-x)); }
DI float fsigmoid(float x) { return __builtin_amdgcn_rcpf(1.f + __expf(-x)); }
DI float wave_sum(float v) {
#pragma unroll
  for (int o = 32; o > 0; o >>= 1) v += __shfl_xor(v, o, 64);
  return v;
}


DI void my_sincos(float x, float* sn, float* cs) {
  const float q = rintf(x * 0.6366197723675814f);
  float r = fmaf(-q, 1.5707962512969971f, x);
  r = fmaf(-q, 7.549789415861596e-08f, r);
  r = fmaf(-q, 5.390302529957765e-15f, r);
  const float r2 = r * r;
  const float sp = r + r * r2 * (-1.6666667e-1f + r2 * (8.3333333e-3f + r2 * (-1.98412698e-4f + r2 * 2.7557319e-6f)));
  const float cp = 1.f + r2 * (-0.5f + r2 * (4.1666667e-2f + r2 * (-1.3888889e-3f + r2 * (2.48015873e-5f - r2 * 2.7557319e-7f))));
  const int qi = ((int)q) & 3;
  const float s_ = (qi & 1) ? cp : sp, c_ = (qi & 1) ? sp : cp;
  *sn = (qi < 2) ? s_ : -s_;
  *cs = (qi == 0 || qi == 3) ? c_ : -c_;
}

struct Params {
  const float *x, *c, *ctx, *c_ctx, *w_mod, *b_mod, *norm1_g, *norm2_g, *w_in, *w_out;
  const float *lam_re, *lam_im, *log_dt, *b_re, *b_im, *c_re, *c_im, *s5_d, *w_glu, *b_glu;
  const float *sink, *hg_lb, *hg_norm_g, *q_norm_g, *w_qb, *kv_norm_g, *w_kvb, *w_up, *w_down, *final_g;
  float* out;
  float *Xc, *mod, *lb, *ropeS, *ropeM, *apow, *bbar, *Ktab;
  bf16_t *Wi, *Wo, *Wu, *Wd, *Wg, *Wq, *Wkv, *TW, *W1;
  bf16_t *Hn;
  bf16_t *H;
  bf16_t *Pu, *PH, *Pm, *Qs, *Ks, *VsT, *Qm, *Km, *VmT, *Yg, *OF, *OB;
  float *Es5, *Eh, *dech;
  unsigned* bar;
};


DI void grid_barrier(unsigned* bar, unsigned ep) {
  asm volatile("s_waitcnt vmcnt(0)" ::: "memory");
  __syncthreads();
  if (threadIdx.x == 0) {
    const unsigned G = gridDim.x, g = blockIdx.x & 7u, nloc = (G - g + 7u) >> 3, ng = G < 8u ? G : 8u;
    __builtin_amdgcn_fence(__ATOMIC_RELEASE, "agent");
    asm volatile("s_waitcnt vmcnt(0)" ::: "memory");
    const unsigned old = __hip_atomic_fetch_add(&bar[64 * g], 1u, __ATOMIC_RELAXED, __HIP_MEMORY_SCOPE_AGENT);
    if (old + 1u == ep * nloc) {
      const unsigned og = __hip_atomic_fetch_add(&bar[1024], 1u, __ATOMIC_RELAXED, __HIP_MEMORY_SCOPE_AGENT);
      if (og + 1u == ep * ng) __hip_atomic_store(&bar[1088], ep, __ATOMIC_RELAXED, __HIP_MEMORY_SCOPE_AGENT);
      else while (__hip_atomic_load(&bar[1088], __ATOMIC_RELAXED, __HIP_MEMORY_SCOPE_AGENT) < ep) __builtin_amdgcn_s_sleep(1);
      __hip_atomic_store(&bar[512 + 64 * g], ep, __ATOMIC_RELAXED, __HIP_MEMORY_SCOPE_AGENT);
    } else {
      while (__hip_atomic_load(&bar[512 + 64 * g], __ATOMIC_RELAXED, __HIP_MEMORY_SCOPE_AGENT) < ep) __builtin_amdgcn_s_sleep(1);
    }
    __builtin_amdgcn_fence(__ATOMIC_ACQUIRE, "agent");
    asm volatile("s_waitcnt vmcnt(0)" ::: "memory");
  }
  __syncthreads();
}

DI const float* xsrc_row(const Params& p, bool first, int row) {
  int b = row / TT, t = row - b * TT;
  if (t < CTXL) return (first ? p.ctx : p.Xc) + ((size_t)b * CTXL + t) * DM;
  return (first ? p.x : p.out) + ((size_t)b * SEQ + (t - CTXL)) * DM;
}
DI float* xdst_row(const Params& p, int row) {
  int b = row / TT, t = row - b * TT;
  if (t < CTXL) return p.Xc + ((size_t)b * CTXL + t) * DM;
  return p.out + ((size_t)b * SEQ + (t - CTXL)) * DM;
}

DI int perm_col(int kind, int n) {
  if (kind == 0) {
    { const int c = n & 63; n = (n & ~63) + ((c >> 2) & 3) * 16 + ((c >> 4) & 3) * 4 + (c & 3); }
    if (n >= NIN) return -1;
    if (n >= 256 && n < 640) { int base = n & ~63, d = n & 63; int a = d >> 5, f = (d & 31) >> 1, hf = d & 1; return base + a * 32 + hf * 16 + f; }
    if (n >= 2432) { int e = n - 2432; int a = e >> 4, f = (e & 15) >> 1, hf = e & 1; return 2432 + a * 16 + hf * 8 + f; }
    return n;
  } else if (kind == 1) {
    int hd = n / 96, dd = n - hd * 96;
    if (dd >= 64) { int e = dd - 64; int a = e >> 4, f = (e & 15) >> 1, hf = e & 1; dd = 64 + a * 16 + hf * 8 + f; }
    return hd * 96 + dd;
  } else if (kind == 2) {
    const int grp = n >> 6, c = n & 63;
    const int nt = (c >> 4) & 3, q4 = (c >> 2) & 3, jj = c & 3;
    return (jj & 1) * FH + grp * 32 + q4 * 8 + nt * 2 + (jj >> 1);
  }
  return n;
}

template <int KT>
DI void conv_tile(float* tile, const float* __restrict__ src, int ldsrc, const float* __restrict__ rscale,
                  bf16_t* __restrict__ dst, int K, int n0, int k0, int kind) {
  const int j = tid_() & 31, i = tid_() >> 5;
  const int sc0 = perm_col(kind, n0 + j);
  const int sc = max(sc0, 0);
  const float scm = sc0 >= 0 ? 1.f : 0.f;
  constexpr int NL = KT / 16;
  float v[NL];
#pragma unroll
  for (int e = 0; e < NL; ++e) v[e] = src[(size_t)(k0 + i + 16 * e) * ldsrc + sc] * scm;
  if (rscale) {
#pragma unroll
    for (int e = 0; e < NL; ++e) v[e] *= rscale[k0 + i + 16 * e];
  }
#pragma unroll
  for (int e = 0; e < NL; ++e) tile[(i + 16 * e) * 33 + j] = v[e];
  __syncthreads();
  const int nn = tid_() >> 4, kq = (tid_() & 15) * 8;
#pragma unroll
  for (int ps = 0; ps < KT / 128; ++ps) {
    float o[8];
#pragma unroll
    for (int e = 0; e < 8; ++e) o[e] = tile[(ps * 128 + kq + e) * 33 + nn];
    *(uint4*)(dst + (size_t)(n0 + nn) * K + k0 + ps * 128 + kq) = make_uint4(pack2(o[0], o[1]), pack2(o[2], o[3]), pack2(o[4], o[5]), pack2(o[6], o[7]));
  }
  __syncthreads();
}

DI void mod_job(float* red, const float* __restrict__ sil, const Params& p, int jm) {
  const int l = jm / 192, cb = (jm % 192) * 32;
  const int j = tid_() & 31, ks = tid_() >> 5;
  const float* wm = p.w_mod + (size_t)l * DM * 6144 + cb + j;
  float a0 = 0, a1 = 0, a2 = 0, a3 = 0, a4 = 0;
  for (int k = ks * 64; k < ks * 64 + 64; ++k) {
    const float w = wm[(size_t)k * 6144];
    a0 += w * sil[k]; a1 += w * sil[1024 + k]; a2 += w * sil[2048 + k]; a3 += w * sil[3072 + k]; a4 += w * sil[4096 + k];
  }
  red[(ks * 32 + j) * 5 + 0] = a0; red[(ks * 32 + j) * 5 + 1] = a1; red[(ks * 32 + j) * 5 + 2] = a2;
  red[(ks * 32 + j) * 5 + 3] = a3; red[(ks * 32 + j) * 5 + 4] = a4;
  __syncthreads();
  if (tid_() < 160) {
    int b = tid_() >> 5, jj = tid_() & 31;
    float s = p.b_mod[l * 6144 + cb + jj];
    for (int q = 0; q < 16; ++q) s += red[(q * 32 + jj) * 5 + b];
    p.mod[(size_t)(l * 5 + b) * 6144 + cb + jj] = s;
  }
  __syncthreads();
}

DI void misc_job(const Params& p) {
  const int tid = tid_();
  if (tid < 256)
  for (int dirn = 0; dirn < 2; ++dirn) {
    float v[4], mx = -1e30f;
    for (int l = 0; l < 4; ++l) { v[l] = p.hg_lb[(dirn * 4 + l) * 256 + tid]; mx = fmaxf(mx, v[l]); }
    float s = 0; for (int l = 0; l < 4; ++l) { v[l] = expf(v[l] - mx); s += v[l]; }
    float cum = 0, first = 0;
    for (int l = 0; l < 4; ++l) { cum += v[l] / s; if (l == 0) first = cum; p.lb[(dirn * 4 + l) * 256 + tid] = cum - first; }
  }
  for (int e = tid; e < 128 * 16; e += NTHR) {
    int pos = e >> 4, f = e & 15;
    float inv = exp2f(-(float)f * (13.287712379549449f / 16.f));
    float ang = (float)pos * inv, sn, cs;
    my_sincos(ang, &sn, &cs);
    p.ropeS[2 * e] = cs; p.ropeS[2 * e + 1] = sn;
  }
  for (int e = tid; e < 128 * 8; e += NTHR) {
    int pos = e >> 3, f = e & 7;
    float inv = exp2f(-(float)f * (13.287712379549449f / 8.f));
    float ang = (float)pos * inv, sn, cs;
    my_sincos(ang, &sn, &cs);
    p.ropeM[2 * e] = cs; p.ropeM[2 * e + 1] = sn;
  }
}

DI void s5tab_job(float* sm, const Params& p, int jb) {
  float2* s_ap = (float2*)sm;
  float2* s_bb = s_ap + 33 * 64;
  float2* s_c = s_bb + 64 * 16;
  const int tid = tid_();
  if (tid < 64) {
    const int pi = jb * 64 + tid;
    float lr = p.lam_re[pi], li = p.lam_im[pi], dt = expf(p.log_dt[pi]);
    float zr = lr * dt, zi = li * dt;
#pragma unroll 1
    for (int t = 0; t <= 32; ++t) {
      float mag = expf((float)t * zr), ang = (float)t * zi, sn, cs;
      my_sincos(ang, &sn, &cs);
      float2 v = make_float2(mag * cs, mag * sn);
      s_ap[t * 64 + tid] = v;
      p.apow[((size_t)jb * 33 + t) * 128 + tid * 2] = v.x;
      p.apow[((size_t)jb * 33 + t) * 128 + tid * 2 + 1] = v.y;
    }
    float cr, ci;
    if (zr * zr + zi * zi < 0.01f) {
      float pr = 1.f, pi_ = 0.f, tr = 1.f, ti = 0.f;
#pragma unroll
      for (int n = 2; n <= 7; ++n) {
        const float nr = (tr * zr - ti * zi) / (float)n, ni = (tr * zi + ti * zr) / (float)n;
        tr = nr; ti = ni; pr += tr; pi_ += ti;
      }
      cr = dt * pr; ci = dt * pi_;
    } else {
      float sn1, cs1;
      my_sincos(zi, &sn1, &cs1);
      const float ar = expf(zr) * cs1 - 1.f, ai = expf(zr) * sn1;
      const float den = lr * lr + li * li;
      cr = (ar * lr + ai * li) / den; ci = (ai * lr - ar * li) / den;
    }
#pragma unroll 1
    for (int hh = 0; hh < 16; ++hh) {
      float br = p.b_re[(size_t)pi * 16 + hh], bi = p.b_im[(size_t)pi * 16 + hh];
      float2 v = make_float2(cr * br - ci * bi, cr * bi + ci * br);
      s_bb[tid * 16 + hh] = v;
      p.bbar[((size_t)pi * 16 + hh) * 2] = v.x; p.bbar[((size_t)pi * 16 + hh) * 2 + 1] = v.y;
    }
  }
  for (int e = tid; e < 1024; e += NTHR) s_c[e] = make_float2(p.c_re[(size_t)jb * 1024 + e], p.c_im[(size_t)jb * 1024 + e]);
  __syncthreads();
  const int hh = (tid >> 4) & 15, hp = tid & 15, th = tid >> 8;
#pragma unroll 1
  for (int t = th; t < 32; t += 2) {
    float acc = 0;
#pragma unroll 4
    for (int q = 0; q < 64; ++q) {
      float2 c = s_c[hh * 64 + q], a = s_ap[t * 64 + q], b = s_bb[q * 16 + hp];
      float wr = c.x * a.x - c.y * a.y, wi = c.x * a.y + c.y * a.x;
      acc += wr * b.x - wi * b.y;
    }
    p.Ktab[((size_t)jb * 32 + t) * 256 + (tid & 255)] = acc;
  }
  __syncthreads();
}

constexpr int J_MOD = 768;
constexpr int CT_WI = 78 * 4, CT_WO = 32 * 4, CT_WU = 176 * 4, CT_WD = 32 * 11, CT_WG = 8 * 1, CT_WQ = 12 * 1, CT_WKV = 16 * 1;
constexpr int CT_LAYER = CT_WI + CT_WO + CT_WU + CT_WD + CT_WG + CT_WQ + CT_WKV;
constexpr int J_CONV = CT_LAYER * DEPTH;
constexpr int J_S5TAB = DEPTH * 2 * 16;

DI void phase_prep(char* smem, const Params& p) {
  float* sm = (float*)smem;
  float* sil = (float*)(smem + 65536);
  for (int e = tid_(); e < 5 * 1024; e += NTHR) {
    const float c = e < 4096 ? p.c[e] : p.c_ctx[e - 4096];
    sil[e] = c * sigmoidf_(c);
  }
  __syncthreads();
  const int total = J_MOD + J_S5TAB + 1 + J_CONV;
  for (int job = bid_(); job < total; job += gridDim.x) {
    int j = job;
    if (j < J_MOD) { mod_job(sm, sil, p, j); continue; }
    j -= J_MOD;
    if (j < J_S5TAB) { s5tab_job(sm, p, j); continue; }
    j -= J_S5TAB;
    if (j < 1) { misc_job(p); continue; }
    j -= 1;
    const int l = j / CT_LAYER; int q = j - l * CT_LAYER;
    if (q < CT_WI) { int nt = q / 4, kt = q % 4; conv_tile<256>(sm, p.w_in + (size_t)l * DM * NIN, NIN, nullptr, p.Wi + (size_t)l * NINP * DM, DM, nt * 32, kt * 256, 0); continue; }
    q -= CT_WI;
    if (q < CT_WO) { int nt = q / 4, kt = q % 4; conv_tile<256>(sm, p.w_out + (size_t)l * DM * DM, DM, nullptr, p.Wo + (size_t)l * DM * DM, DM, nt * 32, kt * 256, 3); continue; }
    q -= CT_WO;
    if (q < CT_WU) { int nt = q / 4, kt = q % 4; conv_tile<256>(sm, p.w_up + (size_t)l * DM * 2 * FH, 2 * FH, nullptr, p.Wu + (size_t)l * 2 * FH * DM, DM, nt * 32, kt * 256, 2); continue; }
    q -= CT_WU;
    if (q < CT_WD) { int nt = q / 11, kt = q % 11; conv_tile<256>(sm, p.w_down + (size_t)l * FH * DM, DM, nullptr, p.Wd + (size_t)l * DM * FH, FH, nt * 32, kt * 256, 3); continue; }
    q -= CT_WD;
    if (q < CT_WG) { int nt = q, kt = 0; conv_tile<256>(sm, p.w_glu + (size_t)l * 65536, 256, nullptr, p.Wg + (size_t)l * 65536, 256, nt * 32, kt * 256, 3); continue; }
    q -= CT_WG;
    if (q < CT_WQ) { int nt = q, kt = 0; conv_tile<256>(sm, p.w_qb + (size_t)l * 256 * 384, 384, p.q_norm_g + l * 256, p.Wq + (size_t)l * 384 * 256, 256, nt * 32, kt * 256, 1); continue; }
    q -= CT_WQ;
    { int nt = q, kt = 0; conv_tile<128>(sm, p.w_kvb + (size_t)l * 128 * 512, 512, p.kv_norm_g + l * 128, p.Wkv + (size_t)l * 512 * 128, 128, nt * 32, kt * 128, 3); }
  }
}

DI void phase_s5mats(const Params& p) {
  const int TW_ROWS = DEPTH * 16 * 512, W1_ROWS = DEPTH * 16 * 256;
  const size_t n_tw = (size_t)TW_ROWS * 96, n_w1 = (size_t)W1_ROWS * 64;
  for (size_t e = (size_t)bid_() * NTHR + tid_(); e < n_tw + n_w1; e += (size_t)gridDim.x * NTHR) {
    float v[8];
    bf16_t* dst;
    if (e < n_tw) {
      const int row = (int)(e / 96), kg = (int)(e % 96);
      const int lg = row >> 9, n = row & 511, t = n >> 4, hh = n & 15;
      const int l = lg >> 4, g = lg & 15;
      const int k = kg * 8;
      dst = p.TW + (size_t)row * 768 + k;
      if (k < 512) {
        const int s = k >> 4, h0 = k & 15;
        const float* Kf = p.Ktab + ((size_t)((l * 2 + 0) * 16 + g) * 32) * 256;
        const float* Kb = p.Ktab + ((size_t)((l * 2 + 1) * 16 + g) * 32) * 256;
        const int ds = t - s, df = ds >= 0 ? ds : 0, db = ds <= 0 ? -ds : 0;
        const float mf = ds >= 0 ? 1.f : 0.f, mb = ds <= 0 ? 1.f : 0.f;
        const float4 f0 = *(const float4*)(Kf + df * 256 + hh * 16 + h0), f1 = *(const float4*)(Kf + df * 256 + hh * 16 + h0 + 4);
        const float4 b0 = *(const float4*)(Kb + db * 256 + hh * 16 + h0), b1 = *(const float4*)(Kb + db * 256 + hh * 16 + h0 + 4);
        v[0] = mf * f0.x + mb * b0.x; v[1] = mf * f0.y + mb * b0.y; v[2] = mf * f0.z + mb * b0.z; v[3] = mf * f0.w + mb * b0.w;
        v[4] = mf * f1.x + mb * b1.x; v[5] = mf * f1.y + mb * b1.y; v[6] = mf * f1.z + mb * b1.z; v[7] = mf * f1.w + mb * b1.w;
        if (ds == 0) {
          const float dsk = p.s5_d[l * 256 + g * 16 + hh];
#pragma unroll
          for (int j = 0; j < 8; ++j) if (hh == h0 + j) v[j] += dsk;
        }
      } else {
        const int dirn = (k - 512) >> 7, p0 = ((k - 512) & 127) >> 1;
        const int jb = (l * 2 + dirn) * 16 + g;
        const int ex = dirn == 0 ? t + 1 : 32 - t;
#pragma unroll
        for (int j = 0; j < 8; ++j) {
          const int pp = p0 + (j >> 1);
          float cr = p.c_re[((size_t)jb * 16 + hh) * 64 + pp], ci = p.c_im[((size_t)jb * 16 + hh) * 64 + pp];
          float ar = p.apow[((size_t)jb * 33 + ex) * 128 + pp * 2], ai = p.apow[((size_t)jb * 33 + ex) * 128 + pp * 2 + 1];
          v[j] = (j & 1) ? -(cr * ai + ci * ar) : (cr * ar - ci * ai);
        }
      }
    } else {
      const size_t e2 = e - n_tw;
      const int row = (int)(e2 / 64), kg = (int)(e2 % 64);
      const int lg = row >> 8, n = row & 255;
      const int l = lg >> 4, g = lg & 15;
      const int dirn = n >> 7, pp = (n & 127) >> 1, ri = n & 1;
      const int k = kg * 8, s = k >> 4, h0 = k & 15;
      const int jb = (l * 2 + dirn) * 16 + g;
      const int ex = dirn == 0 ? 31 - s : s;
      dst = p.W1 + (size_t)row * 512 + k;
      float ar = p.apow[((size_t)jb * 33 + ex) * 128 + pp * 2], ai = p.apow[((size_t)jb * 33 + ex) * 128 + pp * 2 + 1];
#pragma unroll
      for (int j = 0; j < 8; ++j) {
        float br = p.bbar[(((size_t)jb * 64 + pp) * 16 + h0 + j) * 2], bi = p.bbar[(((size_t)jb * 64 + pp) * 16 + h0 + j) * 2 + 1];
        v[j] = ri ? (ar * bi + ai * br) : (ar * br - ai * bi);
      }
    }
    uint4 o; o.x = pack2(v[0], v[1]); o.y = pack2(v[2], v[3]); o.z = pack2(v[4], v[5]); o.w = pack2(v[6], v[7]);
    *(uint4*)dst = o;
  }
}

DI void phase_norm(const Params& p, int layer, int which, bool first) {
  const int w = tid_() >> 6, l = tid_() & 63;
  const float* g = (which ? p.norm2_g : p.norm1_g) + layer * DM;
  for (int row = bid_() * 8 + w; row < R / 2; row += gridDim.x * 8) {
    float4 v[2][4]; float ss[2];
#pragma unroll
    for (int u = 0; u < 2; ++u) {
      const float* xr = xsrc_row(p, first, row + u * (R / 2));
      ss[u] = 0;
#pragma unroll
      for (int i = 0; i < 4; ++i) { v[u][i] = *(const float4*)(xr + i * 256 + l * 4); ss[u] += v[u][i].x * v[u][i].x + v[u][i].y * v[u][i].y + v[u][i].z * v[u][i].z + v[u][i].w * v[u][i].w; }
    }
#pragma unroll
    for (int u = 0; u < 2; ++u) {
      const int rw = row + u * (R / 2);
      const int b = rw / TT, t = rw - b * TT;
      const float* md = p.mod + (size_t)(layer * 5 + (t < CTXL ? 4 : b)) * 6144 + which * 3072;
      const float rs = rsqrtf(wave_sum(ss[u]) * (1.f / DM) + EPSN);
#pragma unroll
      for (int i = 0; i < 4; ++i) {
        const int c = i * 256 + l * 4;
        float4 gg = *(const float4*)(g + c), sh = *(const float4*)(md + c), sc = *(const float4*)(md + 1024 + c);
        float o0 = v[u][i].x * rs * gg.x * (1.f + sc.x) + sh.x, o1 = v[u][i].y * rs * gg.y * (1.f + sc.y) + sh.y;
        float o2 = v[u][i].z * rs * gg.z * (1.f + sc.z) + sh.z, o3 = v[u][i].w * rs * gg.w * (1.f + sc.w) + sh.w;
        uint2 o; o.x = pack2(o0, o1); o.y = pack2(o2, o3);
        *(uint2*)(p.Hn + (size_t)rw * DM + c) = o;
      }
    }
  }
}

DI void phase_final_norm(const Params& p) {
  const int w = tid_() >> 6, l = tid_() & 63;
  constexpr int NR = NBATCH * SEQ;
  for (int row = bid_() * 8 + w; row < NR / 2; row += gridDim.x * 8) {
    float4 v[2][4]; float ss[2];
#pragma unroll
    for (int u = 0; u < 2; ++u) {
      const float* xr = p.out + (size_t)(row + u * (NR / 2)) * DM;
      ss[u] = 0;
#pragma unroll
      for (int i = 0; i < 4; ++i) { v[u][i] = *(const float4*)(xr + i * 256 + l * 4); ss[u] += v[u][i].x * v[u][i].x + v[u][i].y * v[u][i].y + v[u][i].z * v[u][i].z + v[u][i].w * v[u][i].w; }
    }
#pragma unroll
    for (int u = 0; u < 2; ++u) {
      float* xr = p.out + (size_t)(row + u * (NR / 2)) * DM;
      const float rs = rsqrtf(wave_sum(ss[u]) * (1.f / DM) + EPSN);
#pragma unroll
      for (int i = 0; i < 4; ++i) {
        const int c = i * 256 + l * 4;
        float4 gg = *(const float4*)(p.final_g + c);
        *(float4*)(xr + c) = make_float4(v[u][i].x * rs * gg.x, v[u][i].y * rs * gg.y, v[u][i].z * rs * gg.z, v[u][i].w * rs * gg.w);
      }
    }
  }
}

template <int MI = 4, class AL, class EP>
DI void gemm_tile(char* smem, const AL& al, const bf16_t* __restrict__ B, int ldb, int N, const EP& ep, int m0, int n0, int K) {
  bf16_t* sA = (bf16_t*)smem;
  bf16_t* sB = sA + 2 * 256 * 72;
  const int tid = tid_(), w = tid >> 6, l = tid & 63, r = l & 31, h = l >> 5;
  const int wm = w >> 2, wn = w & 3;
  const int lrow = tid >> 3, lk = (tid & 7) * 8;
  f32x16 acc[MI][2];
#pragma unroll
  for (int a = 0; a < MI; ++a)
#pragma unroll
    for (int b = 0; b < 2; ++b)
#pragma unroll
      for (int i = 0; i < 16; ++i) acc[a][b][i] = 0.f;
  const bf16_t* Bp0 = B + (size_t)min(n0 + lrow, N - 1) * ldb + lk;
  const bf16_t* Bp1 = B + (size_t)min(n0 + lrow + 64, N - 1) * ldb + lk;
  const bf16_t* Bp2 = B + (size_t)min(n0 + lrow + 128, N - 1) * ldb + lk;
  const bf16_t* Bp3 = B + (size_t)min(n0 + lrow + 192, N - 1) * ldb + lk;
  uint4 xa0, xa1, xa2, xa3, xb0, xb1, xb2, xb3;
  xa1 = xa2 = xa3 = make_uint4(0, 0, 0, 0);
#define GLOADX(kk) \
  xa0 = al(m0 + lrow, (kk) + lk); if (MI > 1) xa1 = al(m0 + lrow + 64, (kk) + lk); if (MI > 2) { xa2 = al(m0 + lrow + 128, (kk) + lk); xa3 = al(m0 + lrow + 192, (kk) + lk); } \
  xb0 = *(const uint4*)(Bp0 + (kk)); xb1 = *(const uint4*)(Bp1 + (kk)); xb2 = *(const uint4*)(Bp2 + (kk)); xb3 = *(const uint4*)(Bp3 + (kk));
#define SSTOREX(bb) \
  *(uint4*)(sA + (bb) * 18432 + (lrow) * 72 + lk) = xa0; if (MI > 1) *(uint4*)(sA + (bb) * 18432 + (lrow + 64) * 72 + lk) = xa1; \
  if (MI > 2) { *(uint4*)(sA + (bb) * 18432 + (lrow + 128) * 72 + lk) = xa2; *(uint4*)(sA + (bb) * 18432 + (lrow + 192) * 72 + lk) = xa3; } \
  *(uint4*)(sB + (bb) * 18432 + (lrow) * 72 + lk) = xb0; *(uint4*)(sB + (bb) * 18432 + (lrow + 64) * 72 + lk) = xb1; \
  *(uint4*)(sB + (bb) * 18432 + (lrow + 128) * 72 + lk) = xb2; *(uint4*)(sB + (bb) * 18432 + (lrow + 192) * 72 + lk) = xb3;
  const int nk = K >> 6;
  GLOADX(0)
  __syncthreads();
  SSTOREX(0)
  GLOADX(min(1, nk - 1) * 64)
  for (int kt = 0; kt < nk; ++kt) {
    const int buf = kt & 1;
    __syncthreads();
    SSTOREX(buf ^ 1)
    __builtin_amdgcn_sched_barrier(0);
    GLOADX(min(kt + 2, nk - 1) * 64)
    __builtin_amdgcn_sched_barrier(0);
    const bf16_t* cA = sA + buf * 18432 + (wm * 32 * MI + r) * 72 + 8 * h;
    const bf16_t* cB = sB + buf * 18432 + (wn * 64 + r) * 72 + 8 * h;
#pragma unroll
    for (int ks = 0; ks < 4; ++ks) {
      bf16x8 b0 = *(const bf16x8*)(cB + ks * 16), b1 = *(const bf16x8*)(cB + 32 * 72 + ks * 16);
#pragma unroll
      for (int a = 0; a < MI; ++a) {
        bf16x8 af = *(const bf16x8*)(cA + a * 32 * 72 + ks * 16);
        acc[a][0] = MFMA32(b0, af, acc[a][0]);
        acc[a][1] = MFMA32(b1, af, acc[a][1]);
      }
    }
  }
#undef GLOADX
#undef SSTOREX
  const int row0 = m0 + wm * 32 * MI + r, cb0 = n0 + wn * 64 + 4 * h;
  if constexpr (std::is_invocable_v<EP, int, int, int, const f32x16&, const f32x16&>) {
#pragma unroll
    for (int a = 0; a < MI; ++a) ep(row0 + 32 * a, n0 + wn * 64, h, acc[a][0], acc[a][1]);
  } else {
#pragma unroll
    for (int a = 0; a < MI; ++a)
#pragma unroll
      for (int g = 0; g < 4; ++g) {
        ep(row0 + 32 * a, cb0 + 8 * g, acc[a][0][4 * g], acc[a][0][4 * g + 1], acc[a][0][4 * g + 2], acc[a][0][4 * g + 3]);
        ep(row0 + 32 * a, cb0 + 32 + 8 * g, acc[a][1][4 * g], acc[a][1][4 * g + 1], acc[a][1][4 * g + 2], acc[a][1][4 * g + 3]);
      }
  }
}


template <int MI = 4, class EP>
DI void gemm_tile_dma(char* smem, const bf16_t* __restrict__ A, int lda, const bf16_t* __restrict__ B, int ldb, int N,
                      const EP& ep, int m0, int n0, int K) {
  constexpr int STAGE = 65536;
  constexpr int MT = 2 * MI;
  const int tid = tid_(), w = tid >> 6, l = tid & 63, r16 = l & 15, q4 = l >> 4;
  const int wm = w >> 2, wn = w & 3;
  f32x4 acc[MT][4];
#pragma unroll
  for (int a = 0; a < MT; ++a)
#pragma unroll
    for (int b = 0; b < 4; ++b) { acc[a][b][0] = 0.f; acc[a][b][1] = 0.f; acc[a][b][2] = 0.f; acc[a][b][3] = 0.f; }
  const int srow = tid >> 3, slog = (tid & 7) ^ ((tid >> 4) & 7);
  const bf16_t* Ag = A + (size_t)(m0 + srow) * lda + slog * 8;
  const bf16_t* Bg0 = B + (size_t)min(n0 + srow, N - 1) * ldb + slog * 8;
  const bf16_t* Bg1 = B + (size_t)min(n0 + srow + 64, N - 1) * ldb + slog * 8;
  const bf16_t* Bg2 = B + (size_t)min(n0 + srow + 128, N - 1) * ldb + slog * 8;
  const bf16_t* Bg3 = B + (size_t)min(n0 + srow + 192, N - 1) * ldb + slog * 8;
  char* wbase = smem + w * 1024;
#define DMA16(g, lds) __builtin_amdgcn_global_load_lds((const unsigned*)(g), (unsigned*)(lds), 16, 0, 0)
#define STAGE_TILE(bb, kk) { char* sb_ = wbase + (bb) * STAGE; \
    DMA16(Ag + (kk), sb_); \
    if (MI > 1) DMA16(Ag + (size_t)64 * lda + (kk), sb_ + 8192); \
    if (MI > 2) { DMA16(Ag + (size_t)128 * lda + (kk), sb_ + 16384); DMA16(Ag + (size_t)192 * lda + (kk), sb_ + 24576); } \
    DMA16(Bg0 + (kk), sb_ + 32768); DMA16(Bg1 + (kk), sb_ + 32768 + 8192); \
    DMA16(Bg2 + (kk), sb_ + 32768 + 16384); DMA16(Bg3 + (kk), sb_ + 32768 + 24576); }
  const int nk = K >> 6;
  __syncthreads();
  STAGE_TILE(0, 0)
  asm volatile("s_waitcnt vmcnt(0)" ::: "memory");
  __syncthreads();
  const int swz = r16 >> 1;
  for (int kt = 0; kt < nk; ++kt) {
    const int buf = kt & 1;
    const char* cA = smem + buf * STAGE + (wm * 32 * MI + r16) * 128;
    const char* cB = smem + buf * STAGE + 32768 + (wn * 64 + r16) * 128;
#pragma unroll
    for (int k2 = 0; k2 < 2; ++k2) {
      if (k2 == 1 && kt + 1 < nk) STAGE_TILE(buf ^ 1, (kt + 1) * 64)
      const int po = ((4 * k2 + q4) ^ swz) * 16;
      bf16x8 bf[4];
#pragma unroll
      for (int nt = 0; nt < 4; ++nt) bf[nt] = *(const bf16x8*)(cB + nt * 16 * 128 + po);
      bf16x8 afc = *(const bf16x8*)(cA + po);
#pragma unroll
      for (int a = 0; a < MT; ++a) {
        bf16x8 afn = afc;
        if (a + 1 < MT) afn = *(const bf16x8*)(cA + (a + 1) * 16 * 128 + po);
        __builtin_amdgcn_sched_barrier(0);
#pragma unroll
        for (int nt = 0; nt < 4; ++nt) acc[a][nt] = MFMA16(bf[nt], afc, acc[a][nt]);
        __builtin_amdgcn_sched_barrier(0);
        afc = afn;
      }
    }
    asm volatile("s_waitcnt vmcnt(0)" ::: "memory");
    __syncthreads();
  }
#undef DMA16
#undef STAGE_TILE
  const int row0 = m0 + wm * 32 * MI + r16, cbw = n0 + wn * 64;
  if constexpr (std::is_invocable_v<EP, int, int, int, const f32x4&, const f32x4&, const f32x4&, const f32x4&>) {
#pragma unroll
    for (int a = 0; a < MT; ++a) ep(row0 + 16 * a, cbw, q4, acc[a][0], acc[a][1], acc[a][2], acc[a][3]);
  } else {
#pragma unroll
    for (int a = 0; a < MT; ++a)
#pragma unroll
      for (int nt = 0; nt < 4; ++nt)
        ep(row0 + 16 * a, cbw + 16 * nt + 4 * q4, acc[a][nt][0], acc[a][nt][1], acc[a][nt][2], acc[a][nt][3]);
  }
}

DI void row_rms(float* rs, const bf16_t* __restrict__ A, int lda, int m0, int K) {
  const int row = tid_() >> 1, hf = tid_() & 1;
  const bf16_t* a = A + (size_t)(m0 + row) * lda + hf * (K >> 1);
  float ss = 0;
  for (int k = 0; k < (K >> 1); k += 8) {
    uint4 v = *(const uint4*)(a + k);
    float lo, hi;
    lo = __uint_as_float(v.x << 16); hi = __uint_as_float(v.x & 0xffff0000u); ss += lo * lo + hi * hi;
    lo = __uint_as_float(v.y << 16); hi = __uint_as_float(v.y & 0xffff0000u); ss += lo * lo + hi * hi;
    lo = __uint_as_float(v.z << 16); hi = __uint_as_float(v.z & 0xffff0000u); ss += lo * lo + hi * hi;
    lo = __uint_as_float(v.w << 16); hi = __uint_as_float(v.w & 0xffff0000u); ss += lo * lo + hi * hi;
  }
  ss += __shfl_xor(ss, 1, 64);
  __syncthreads();
  if (hf == 0) rs[row] = rsqrtf(ss / (float)K + EPSN);
  __syncthreads();
}

template <int TMI, class F>
DI void for_tiles_xcd(int MT, int NT, const F& f) {
  const int total = MT * NT, G = gridDim.x, nslots = G >> 3;
  const int b = bid_(), x = b & 7, slot = b >> 3;
  const int total_full = (total / G) * G;
  const int full = (MT >> 3) * 8 * NT, gsz = MT - (MT >> 3) * 8;
  auto decode = [&](int L, int& mt, int& nt) {
    if (L < full) { const int mg = L / (8 * NT), rem = L - mg * 8 * NT; mt = mg * 8 + (rem & 7); nt = rem >> 3; }
    else { const int rem = L - full; nt = rem / gsz; mt = (MT >> 3) * 8 + (rem - nt * gsz); }
  };
  if (slot < nslots)
    for (int c = x; c * 32 < total_full; c += 8)
      for (int kk = slot; kk < 32; kk += nslots) {
        const int L = c * 32 + kk;
        if (L >= total_full) break;
        int mt, nt; decode(L, mt, nt);
        f(mt * 256, nt, std::integral_constant<int, 4>{});
      }
  constexpr int PIECES = 4 / TMI;
  const int npieces = (total - total_full) * PIECES;
  for (int q = b; q < npieces; q += G) {
    int mt, nt; decode(total_full + q / PIECES, mt, nt);
    f(mt * 256 + (q % PIECES) * 64 * TMI, nt, std::integral_constant<int, TMI>{});
  }
}

DI void phase_win(char* smem, const Params& p, int layer) {
  const bf16_t* Hn = p.Hn;
  auto al = [=](int row, int k) -> uint4 { return *(const uint4*)(Hn + (size_t)row * DM + k); };
  const float qscale = 0.125f * LOG2E;
  auto ep = [&](int row, int cbw, int q4, const f32x4& c0, const f32x4& c1, const f32x4& c2, const f32x4& c3) {
    if (cbw > 2432) return;
    const int b = row / TT, t = row - b * TT;
    const bool lat = t >= CTXL;
    const int pos = t - CTXL;
    float v[16] = {c0[0], c0[1], c0[2], c0[3], c1[0], c1[1], c1[2], c1[3], c2[0], c2[1], c2[2], c2[3], c3[0], c3[1], c3[2], c3[3]};
    if (cbw >= 640 && cbw < 768) {
      bf16_t* vp = p.VsT + ((size_t)(b * 2 + ((cbw - 640) >> 6)) * 64 + q4 * 16) * TT + t;
#pragma unroll
      for (int i = 0; i < 16; ++i) vp[(size_t)i * TT] = f2bf(v[i]);
      return;
    }
    const bool r16 = cbw >= 256 && cbw < 640, rkr = cbw == 2432;
    if (rkr && q4 >= 2) return;
    if (lat && (r16 || rkr)) {
      const int a = r16 ? (q4 >> 1) : q4;
      const int pa = a ? (pos & 63) : (pos >> 6);
      const float* tab = r16 ? p.ropeS + 2 * (pa * 16 + (q4 & 1) * 8) : p.ropeM + 2 * (pa * 8);
#pragma unroll
      for (int k = 0; k < 4; ++k) {
        const float4 cs = *(const float4*)(tab + 4 * k);
        const float x0 = v[4 * k], x1 = v[4 * k + 1], x2 = v[4 * k + 2], x3 = v[4 * k + 3];
        v[4 * k] = x0 * cs.x - x1 * cs.y; v[4 * k + 1] = x1 * cs.x + x0 * cs.y;
        v[4 * k + 2] = x2 * cs.z - x3 * cs.w; v[4 * k + 3] = x3 * cs.z + x2 * cs.w;
      }
    }
    if (cbw >= 256 && cbw < 512) {
#pragma unroll
      for (int i = 0; i < 16; ++i) v[i] *= qscale;
    }
    const uint4 lo = make_uint4(pack2(v[0], v[1]), pack2(v[2], v[3]), pack2(v[4], v[5]), pack2(v[6], v[7]));
    const uint4 hi = make_uint4(pack2(v[8], v[9]), pack2(v[10], v[11]), pack2(v[12], v[13]), pack2(v[14], v[15]));
    if (rkr) {
#pragma unroll
      for (int hd = 0; hd < 4; ++hd) {
        bf16_t* d = p.Km + ((size_t)(b * 4 + hd) * TT + t) * 96 + 64 + q4 * 16;
        *(uint4*)d = lo; *(uint4*)(d + 8) = hi;
      }
      return;
    }
    bf16_t* d;
    if (cbw < 256) d = p.Pu + (size_t)row * 256 + cbw;
    else if (cbw < 512) d = p.Qs + ((size_t)(b * 4 + ((cbw - 256) >> 6)) * TT + t) * 64;
    else if (cbw < 640) d = p.Ks + ((size_t)(b * 2 + ((cbw - 512) >> 6)) * TT + t) * 64;
    else if (cbw < 2048) d = p.PH + (size_t)row * 1280 + (cbw - 768);
    else d = p.Pm + (size_t)row * 384 + (cbw - 2048);
    d += q4 * 16;
    *(uint4*)d = lo; *(uint4*)(d + 8) = hi;
  };
  const bf16_t* W = p.Wi + (size_t)layer * NINP * DM;
  for_tiles_xcd<1>(R / 256, 10, [&](int m0, int nt, auto mi) { gemm_tile_dma<decltype(mi)::value>(smem, Hn, DM, W, DM, NINP, ep, m0, nt * 256, DM); });
}

DI int hg_tok(int dirn, int j) { return dirn == 0 ? j : (j < CTXL ? CTXL - 1 - j : TT + CTXL - 1 - j); }

template <bool FULL>
DI void hg_item(char* smem, const Params& p, int layer, int item) {
  bf16_t* qd = (bf16_t*)(smem + (tid_() >> 8) * 36864);
  bf16_t* ki = qd + 32 * 72;
  bf16_t* keT = ki + 32 * 72;
  bf16_t* vT = keT + 64 * 40;
  bf16_t* att = vT + 64 * 40;
  bf16_t* ST = att + 32 * 40;
  float* tot = (float*)(ST + 64 * 72);
  float* decs = tot + 256;
  const int tid = tid_() & 255, half = tid_() >> 8, w = tid >> 6, l = tid & 63, r16 = l & 15, q4 = l >> 4;
  item = item * 2 + half;
  const int sc = item % NSC, chain = item / NSC;
  const int dirn = chain & 1, head = (chain >> 1) & 3, b = chain >> 3;
  const int d = l, tq = w;
  __syncthreads();
  const float lbv = p.lb[(dirn * 4 + layer) * 256 + head * 64 + d];
  bf16_t* Odir = dirn ? p.OB : p.OF;
  float* Est = p.Eh + (size_t)item * 4096;
  f32x4 sacc[4];
#pragma unroll
  for (int di = 0; di < 4; ++di)
#pragma unroll
    for (int jj = 0; jj < 4; ++jj) {
      if (FULL) {
        const int v = w * 16 + q4 * 4 + jj, dd = di * 16 + r16;
        const float s0 = Est[v * 64 + dd];
        sacc[di][jj] = s0;
        ST[v * 72 + dd] = f2bf(s0);
      } else sacc[di][jj] = 0.f;
    }
  float dprod = 1.f;
  __syncthreads();
  bf16_t pz[4][8], pq[4][8], pv[4][8];
#pragma unroll
  for (int sub = 0; sub < 4; ++sub)
#pragma unroll
    for (int ii = 0; ii < 8; ++ii) {
      const int t = hg_tok(dirn, sc * 128 + sub * 32 + tq * 8 + ii);
      const bf16_t* ph = p.PH + ((size_t)b * TT + t) * 1280 + head * 64 + d;
      pz[sub][ii] = ph[dirn ? 512 : 256];
      if (FULL) pq[sub][ii] = ph[0];
      pv[sub][ii] = ph[768];
    }
#pragma unroll
  for (int sub = 0; sub < 4; ++sub) {
    const int j0 = sc * 128 + sub * 32;
    float cum[8], kk[8], qv[8], vv[8];
    float csum = 0;
#pragma unroll
    for (int ii = 0; ii < 8; ++ii) {
      const float z = bf2f(pz[sub][ii]);
      qv[ii] = FULL ? bf2f(pq[sub][ii]) : 0.f; vv[ii] = bf2f(pv[sub][ii]);
      const float sg = __builtin_amdgcn_rcpf(1.f + __expf(-z)), sgn = __builtin_amdgcn_rcpf(1.f + __expf(z));
      const float f = lbv + (1.f - lbv) * sg;
      kk[ii] = (1.f - lbv) * sgn;
      csum += __logf(f);
      cum[ii] = csum;
    }
    tot[tq * 64 + d] = csum;
    __syncthreads();
    float off = 0, last = 0;
#pragma unroll
    for (int q = 0; q < 4; ++q) { const float tv = tot[q * 64 + d]; last += tv; if (q < tq) off += tv; }
#pragma unroll
    for (int ii = 0; ii < 8; ++ii) {
      const int i = tq * 8 + ii;
      const float cu = off + cum[ii];
      if (FULL) { qd[i * 72 + d] = f2bf(qv[ii] * __expf(cu)); ki[i * 72 + d] = f2bf(kk[ii] * __expf(-cu)); }
      keT[d * 40 + i] = f2bf(kk[ii] * __expf(last - cu));
      vT[d * 40 + i] = f2bf(vv[ii]);
    }
    const float dl = __expf(last);
    if (tq == 0) { decs[d] = dl; dprod *= dl; }
    __syncthreads();
    if (FULL) {
      const int ti = w >> 1, si = w & 1;
      f32x4 acc = {0.f, 0.f, 0.f, 0.f};
#pragma unroll
      for (int ks = 0; ks < 2; ++ks) {
        bf16x8 a = *(const bf16x8*)(qd + (ti * 16 + r16) * 72 + ks * 32 + q4 * 8);
        bf16x8 bb = *(const bf16x8*)(ki + (si * 16 + r16) * 72 + ks * 32 + q4 * 8);
        acc = MFMA16(a, bb, acc);
      }
#pragma unroll
      for (int jj = 0; jj < 4; ++jj) {
        const int t = ti * 16 + q4 * 4 + jj, s = si * 16 + r16;
        att[t * 40 + s] = f2bf(s <= t ? acc[jj] : 0.f);
      }
      __syncthreads();
#pragma unroll
      for (int ti2 = 0; ti2 < 2; ++ti2) {
        f32x4 oacc = {0.f, 0.f, 0.f, 0.f};
        {
          bf16x8 a = *(const bf16x8*)(att + (ti2 * 16 + r16) * 40 + q4 * 8);
          bf16x8 bb = *(const bf16x8*)(vT + (w * 16 + r16) * 40 + q4 * 8);
          oacc = MFMA16(a, bb, oacc);
        }
#pragma unroll
        for (int ks = 0; ks < 2; ++ks) {
          bf16x8 a = *(const bf16x8*)(qd + (ti2 * 16 + r16) * 72 + ks * 32 + q4 * 8);
          bf16x8 bb = *(const bf16x8*)(ST + (w * 16 + r16) * 72 + ks * 32 + q4 * 8);
          oacc = MFMA16(a, bb, oacc);
        }
#pragma unroll
        for (int jj = 0; jj < 4; ++jj) {
          const int i = ti2 * 16 + q4 * 4 + jj;
          const int t = hg_tok(dirn, j0 + i);
          Odir[((size_t)b * TT + t) * 256 + head * 64 + w * 16 + r16] = f2bf(oacc[jj]);
        }
      }
    }
#pragma unroll
    for (int di = 0; di < 4; ++di) {
      bf16x8 a = *(const bf16x8*)(vT + (w * 16 + r16) * 40 + q4 * 8);
      bf16x8 bb = *(const bf16x8*)(keT + (di * 16 + r16) * 40 + q4 * 8);
      const float dc = decs[di * 16 + r16];
      f32x4 sv = sacc[di];
      sv[0] *= dc; sv[1] *= dc; sv[2] *= dc; sv[3] *= dc;
      sacc[di] = MFMA16(a, bb, sv);
    }
    if (FULL) {
      __syncthreads();
#pragma unroll
      for (int di = 0; di < 4; ++di)
#pragma unroll
        for (int jj = 0; jj < 4; ++jj) ST[(w * 16 + q4 * 4 + jj) * 72 + di * 16 + r16] = f2bf(sacc[di][jj]);
    }
  }
  if (!FULL) {
#pragma unroll
    for (int di = 0; di < 4; ++di)
#pragma unroll
      for (int jj = 0; jj < 4; ++jj) Est[(w * 16 + q4 * 4 + jj) * 64 + di * 16 + r16] = sacc[di][jj];
    if (tq == 0) p.dech[(size_t)item * 64 + d] = dprod;
  }
  __syncthreads();
}

DI void phase_B(char* smem, const Params& p, int layer) {
  float* rs = (float*)(smem + 147456);
  const int J_E = 16 * 5, J_Q = 132 * 2, J_KV = 132 * 2, J_HG2 = NBATCH * 4 * 2 * NSC / 2;
  const float mscale = 0.10206207261596575f * LOG2E;
  const int G = gridDim.x;
  for (int j = bid_(); j < J_HG2; j += G) hg_item<false>(smem, p, layer, j);
  for (int j = (bid_() + G - (J_HG2 % G)) % G; j < J_E; j += G) {
    const int g = j / 5, mt = j % 5;
    const bf16_t* Pu = p.Pu;
    auto al = [=](int row, int k) -> uint4 {
      row = min(row, NCHR - 1);
      return *(const uint4*)(Pu + ((size_t)row * 32 + (k >> 4)) * 256 + g * 16 + (k & 15));
    };
    float* Es5 = p.Es5;
    auto ep = [=](int row, int col, float v0, float v1, float v2, float v3) { if (row < NCHR) *(float4*)(Es5 + ((size_t)row * 16 + g) * 256 + col) = make_float4(v0, v1, v2, v3); };
    gemm_tile(smem, al, p.W1 + (size_t)(layer * 16 + g) * 256 * 512, 512, 256, ep, mt * 256, 0, 512);
  }
  for (int j = (bid_() + G - ((J_HG2 + J_E) % G)) % G; j < J_Q; j += G) {
    const int mt = j >> 1, nt = j & 1;
    row_rms(rs, p.Pm, 384, mt * 256, 256);
    const bf16_t* Pm = p.Pm;
    auto al = [=](int row, int k) -> uint4 { return *(const uint4*)(Pm + (size_t)row * 384 + k); };
    const float* ropeM = p.ropeM; bf16_t* Qm = p.Qm;
    auto ep = [=](int row, int col, float v0, float v1, float v2, float v3) {
      if (col >= 384) return;
      const int b = row / TT, t = row - b * TT;
      const int hd = col / 96, dd = col - hd * 96;
      const float rr = rs[row - mt * 256] * mscale;
      v0 *= rr; v1 *= rr; v2 *= rr; v3 *= rr;
      if (dd >= 64 && t >= CTXL) {
        const int e = dd - 64, pos = t - CTXL;
        const int a = e >> 4, f = (e & 15) >> 1;
        const int pa = a ? (pos & 63) : (pos >> 6);
        const float4 cs = *(const float4*)(ropeM + 2 * (pa * 8 + f));
        const float o0 = v0 * cs.x - v1 * cs.y, o1 = v1 * cs.x + v0 * cs.y;
        const float o2 = v2 * cs.z - v3 * cs.w, o3 = v3 * cs.z + v2 * cs.w;
        v0 = o0; v1 = o1; v2 = o2; v3 = o3;
      }
      *(uint2*)(Qm + ((size_t)(b * 4 + hd) * TT + t) * 96 + dd) = make_uint2(pack2(v0, v1), pack2(v2, v3));
    };
    gemm_tile_dma<4>(smem, p.Pm, 384, p.Wq + (size_t)layer * 384 * 256, 256, 384, ep, mt * 256, nt * 256, 256);
  }
  for (int j = (bid_() + G - ((J_HG2 + J_E + J_Q) % G)) % G; j < J_KV; j += G) {
    const int mt = j >> 1, nt = j & 1;
    row_rms(rs, p.Pm + 256, 384, mt * 256, 128);
    const bf16_t* Pm = p.Pm + 256;
    auto al = [=](int row, int k) -> uint4 { return *(const uint4*)(Pm + (size_t)row * 384 + k); };
    bf16_t* Km = p.Km; bf16_t* VmT = p.VmT;
    auto ep = [=](int row, int col, float v0, float v1, float v2, float v3) {
      const int b = row / TT, t = row - b * TT;
      const int hd = col >> 7, jj = col & 127;
      const float rr = rs[row - mt * 256];
      v0 *= rr; v1 *= rr; v2 *= rr; v3 *= rr;
      if (jj < 64) *(uint2*)(Km + ((size_t)(b * 4 + hd) * TT + t) * 96 + jj) = make_uint2(pack2(v0, v1), pack2(v2, v3));
      else {
        bf16_t* vp = VmT + ((size_t)(b * 4 + hd) * 64 + (jj - 64)) * TT + t;
        vp[0] = f2bf(v0); vp[TT] = f2bf(v1); vp[2 * TT] = f2bf(v2); vp[3 * TT] = f2bf(v3);
      }
    };
    gemm_tile_dma<4>(smem, p.Pm + 256, 384, p.Wkv + (size_t)layer * 512 * 128, 128, 512, ep, mt * 256, nt * 256, 128);
  }
}

template <int DQK, bool WINDOW>
DI void attn_item(char* smem, const bf16_t* __restrict__ Q, const bf16_t* __restrict__ K, const bf16_t* __restrict__ VT,
                  int qh, int kvh, int b, int q0, bool has_sink, float sink_l2, bf16_t* __restrict__ Y, int ycol) {
  constexpr int KS = DQK / 16, KSTR = DQK + 8, VSTR = 72, KV8 = DQK / 8;
  bf16_t* sK = (bf16_t*)smem;
  bf16_t* sV = sK + 64 * KSTR;
  const int tid = tid_(), w = tid >> 6, l = tid & 63, r = l & 31, h = l >> 5;
  bf16x8 qf[KS];
  {
    const bf16_t* qp = Q + ((size_t)qh * TT + q0 + w * 32 + r) * DQK + 8 * h;
#pragma unroll
    for (int ks = 0; ks < KS; ++ks) qf[ks] = *(const bf16x8*)(qp + ks * 16);
  }
  f32x16 o0, o1;
#pragma unroll
  for (int i = 0; i < 16; ++i) { o0[i] = 0; o1[i] = 0; }
  float m = 0.f, lsum = 0.f;
  int lo, hi;
  if (q0 < CTXL) { lo = CTXL; hi = CTXL; }
  else if (WINDOW) { lo = max(CTXL, q0 - 128); hi = min(TT, q0 + 256 + 128); }
  else { lo = CTXL; hi = TT; }
  const int ntiles = 4 + ((hi - lo) >> 6);
  const bf16_t* Kb = K + (size_t)kvh * TT * DQK;
  const bf16_t* Vb = VT + (size_t)kvh * 64 * TT;
  const int qpos = q0 + w * 32 + r;
  constexpr bool K2 = (64 * KV8) > NTHR;
  constexpr int BUFE = 64 * KSTR + 64 * VSTR;
  uint4 kr0, kr1, vr0;
  kr1 = make_uint4(0, 0, 0, 0);
  const int kidx1 = K2 ? min(tid + NTHR, 64 * KV8 - 1) : 0;
  const int krow0 = tid / KV8, kcc0 = tid - krow0 * KV8, krow1 = kidx1 / KV8, kcc1 = kidx1 - krow1 * KV8;
  const int vrow0 = tid >> 3, vcc0 = tid & 7;
#define TILE_K0(i) ((i) < 4 ? (i) * 64 : lo + ((i) - 4) * 64)
#define ALOAD(i) { const int kk0 = TILE_K0(i); \
    kr0 = *(const uint4*)(Kb + (size_t)(kk0 + krow0) * DQK + kcc0 * 8); \
    if (K2) kr1 = *(const uint4*)(Kb + (size_t)(kk0 + krow1) * DQK + kcc1 * 8); \
    vr0 = *(const uint4*)(Vb + (size_t)vrow0 * TT + kk0 + vcc0 * 8); }
#define ASTORE(bb) { bf16_t* dK = (bf16_t*)smem + (bb) * BUFE; bf16_t* dV = dK + 64 * KSTR; \
    *(uint4*)(dK + krow0 * KSTR + kcc0 * 8) = kr0; \
    if (K2) *(uint4*)(dK + krow1 * KSTR + kcc1 * 8) = kr1; \
    *(uint4*)(dV + vrow0 * VSTR + vcc0 * 8) = vr0; }
  ALOAD(0)
  __syncthreads();
  ASTORE(0)
  ALOAD(min(1, ntiles - 1))
  for (int it = 0; it < ntiles; ++it) {
    const int k0 = TILE_K0(it);
    __syncthreads();
    ASTORE((it + 1) & 1)
    __builtin_amdgcn_sched_barrier(0);
    ALOAD(min(it + 2, ntiles - 1))
    __builtin_amdgcn_sched_barrier(0);
    sK = (bf16_t*)smem + (it & 1) * BUFE;
    sV = sK + 64 * KSTR;
    f32x16 s0, s1;
    const float ninit = -m;
#pragma unroll
    for (int i = 0; i < 16; ++i) { s0[i] = ninit; s1[i] = ninit; }
#pragma unroll
    for (int ks = 0; ks < KS; ++ks) {
      bf16x8 a0 = *(const bf16x8*)(sK + r * KSTR + ks * 16 + 8 * h);
      bf16x8 a1 = *(const bf16x8*)(sK + (32 + r) * KSTR + ks * 16 + 8 * h);
      s0 = MFMA32(a0, qf[ks], s0);
      s1 = MFMA32(a1, qf[ks], s1);
    }
    if (WINDOW && k0 >= CTXL) {
#pragma unroll
      for (int i = 0; i < 16; ++i) {
        const int kp = k0 + crow(i, h);
        if (abs(qpos - kp) > 128) s0[i] = -1e30f;
        if (abs(qpos - kp - 32) > 128) s1[i] = -1e30f;
      }
    }
    int mxb = max(__float_as_int(s0[0]), __float_as_int(s1[0]));
#pragma unroll
    for (int i = 1; i < 16; ++i) mxb = max(mxb, max(__float_as_int(s0[i]), __float_as_int(s1[i])));
    if (__any((it == 0) || (mxb > 0x41000000))) {
      float mx = -1e30f;
#pragma unroll
      for (int i = 0; i < 16; ++i) mx = fmaxf(mx, fmaxf(s0[i], s1[i]));
      mx = fmaxf(mx, __shfl_xor(mx, 32, 64));
      const float delta = (it == 0) ? mx : fmaxf(mx, 0.f);
      const float alpha = (it == 0) ? 1.f : __builtin_amdgcn_exp2f(-delta);
      m += delta;
      lsum *= alpha;
#pragma unroll
      for (int i = 0; i < 16; ++i) { o0[i] *= alpha; o1[i] *= alpha; s0[i] -= delta; s1[i] -= delta; }
    }
    float rsum = 0;
#pragma unroll
    for (int i = 0; i < 16; ++i) { s0[i] = __builtin_amdgcn_exp2f(s0[i]); s1[i] = __builtin_amdgcn_exp2f(s1[i]); rsum += s0[i] + s1[i]; }
    rsum += __shfl_xor(rsum, 32, 64);
    lsum += rsum;
#pragma unroll
    for (int mt = 0; mt < 2; ++mt) {
#pragma unroll
      for (int s = 0; s < 2; ++s) {
        union { bf16x8 v; unsigned u[4]; } pk;
        if (mt == 0) {
          pk.u[0] = pack2(s0[8 * s + 0], s0[8 * s + 1]); pk.u[1] = pack2(s0[8 * s + 2], s0[8 * s + 3]);
          pk.u[2] = pack2(s0[8 * s + 4], s0[8 * s + 5]); pk.u[3] = pack2(s0[8 * s + 6], s0[8 * s + 7]);
        } else {
          pk.u[0] = pack2(s1[8 * s + 0], s1[8 * s + 1]); pk.u[1] = pack2(s1[8 * s + 2], s1[8 * s + 3]);
          pk.u[2] = pack2(s1[8 * s + 4], s1[8 * s + 5]); pk.u[3] = pack2(s1[8 * s + 6], s1[8 * s + 7]);
        }
        const int base = mt * 32 + s * 16 + 4 * h;
        union { bf16x8 v; uint2 u[2]; } va, vb;
        va.u[0] = *(const uint2*)(sV + r * VSTR + base);
        va.u[1] = *(const uint2*)(sV + r * VSTR + base + 8);
        vb.u[0] = *(const uint2*)(sV + (32 + r) * VSTR + base);
        vb.u[1] = *(const uint2*)(sV + (32 + r) * VSTR + base + 8);
        o0 = MFMA32(va.v, pk.v, o0);
        o1 = MFMA32(vb.v, pk.v, o1);
      }
    }
  }
#undef TILE_K0
#undef ALOAD
#undef ASTORE
  float lt = lsum;
  if (has_sink) lt += __builtin_amdgcn_exp2f(sink_l2 - m);
  const float inv = 1.f / lt;
  bf16_t* yp = Y + ((size_t)b * TT + qpos) * DM + ycol;
#pragma unroll
  for (int g = 0; g < 4; ++g) {
    uint2 u0, u1;
    u0.x = pack2(o0[4 * g] * inv, o0[4 * g + 1] * inv); u0.y = pack2(o0[4 * g + 2] * inv, o0[4 * g + 3] * inv);
    u1.x = pack2(o1[4 * g] * inv, o1[4 * g + 1] * inv); u1.y = pack2(o1[4 * g + 2] * inv, o1[4 * g + 3] * inv);
    *(uint2*)(yp + 8 * g + 4 * h) = u0;
    *(uint2*)(yp + 32 + 8 * g + 4 * h) = u1;
  }
}

template <int DQK>
DI void attn_item2(char* smem, const bf16_t* __restrict__ Q, const bf16_t* __restrict__ K, const bf16_t* __restrict__ VT,
                   int qh, int kvh, int b, int q0, bf16_t* __restrict__ Y, int ycol) {
  constexpr int KS = DQK / 16, KSTR = DQK + 8, VSTR = 72, KV8 = DQK / 8;
  const int tid = tid_(), w = tid >> 6, l = tid & 63, r = l & 31, h = l >> 5;
  bf16x8 qf[2][KS];
#pragma unroll
  for (int qn = 0; qn < 2; ++qn) {
    const bf16_t* qp = Q + ((size_t)qh * TT + q0 + w * 64 + qn * 32 + r) * DQK + 8 * h;
#pragma unroll
    for (int ks = 0; ks < KS; ++ks) qf[qn][ks] = *(const bf16x8*)(qp + ks * 16);
  }
  f32x16 o[2][2];
#pragma unroll
  for (int qn = 0; qn < 2; ++qn)
#pragma unroll
    for (int i = 0; i < 16; ++i) { o[qn][0][i] = 0; o[qn][1][i] = 0; }
  float m[2] = {0.f, 0.f}, lsum[2] = {0.f, 0.f};
  const int ntiles = TT / 64;
  const bf16_t* Kb = K + (size_t)kvh * TT * DQK;
  const bf16_t* Vb = VT + (size_t)kvh * 64 * TT;
  constexpr bool K2 = (64 * KV8) > NTHR;
  constexpr int BUFE = 64 * KSTR + 64 * VSTR;
  uint4 kr0, kr1, vr0;
  kr1 = make_uint4(0, 0, 0, 0);
  const int kidx1 = K2 ? min(tid + NTHR, 64 * KV8 - 1) : 0;
  const int krow0 = tid / KV8, kcc0 = tid - krow0 * KV8, krow1 = kidx1 / KV8, kcc1 = kidx1 - krow1 * KV8;
  const int vrow0 = tid >> 3, vcc0 = tid & 7;
#define ALOAD(i) { const int kk0 = (i) * 64; \
    kr0 = *(const uint4*)(Kb + (size_t)(kk0 + krow0) * DQK + kcc0 * 8); \
    if (K2) kr1 = *(const uint4*)(Kb + (size_t)(kk0 + krow1) * DQK + kcc1 * 8); \
    vr0 = *(const uint4*)(Vb + (size_t)vrow0 * TT + kk0 + vcc0 * 8); }
#define ASTORE(bb) { bf16_t* dK = (bf16_t*)smem + (bb) * BUFE; bf16_t* dV = dK + 64 * KSTR; \
    *(uint4*)(dK + krow0 * KSTR + kcc0 * 8) = kr0; \
    if (K2) *(uint4*)(dK + krow1 * KSTR + kcc1 * 8) = kr1; \
    *(uint4*)(dV + vrow0 * VSTR + vcc0 * 8) = vr0; }
  ALOAD(0)
  __syncthreads();
  ASTORE(0)
  ALOAD(1)
  for (int it = 0; it < ntiles; ++it) {
    __syncthreads();
    const bf16_t* sK = (const bf16_t*)smem + (it & 1) * BUFE;
    const bf16_t* sV = sK + 64 * KSTR;
    f32x16 s[2][2];
#pragma unroll
    for (int qn = 0; qn < 2; ++qn) {
      const float ninit = -m[qn];
#pragma unroll
      for (int i = 0; i < 16; ++i) { s[qn][0][i] = ninit; s[qn][1][i] = ninit; }
    }
#pragma unroll
    for (int ks = 0; ks < KS; ++ks) {
      bf16x8 a0 = *(const bf16x8*)(sK + r * KSTR + ks * 16 + 8 * h);
      bf16x8 a1 = *(const bf16x8*)(sK + (32 + r) * KSTR + ks * 16 + 8 * h);
#pragma unroll
      for (int qn = 0; qn < 2; ++qn) {
        s[qn][0] = MFMA32(a0, qf[qn][ks], s[qn][0]);
        s[qn][1] = MFMA32(a1, qf[qn][ks], s[qn][1]);
      }
    }
    __builtin_amdgcn_sched_barrier(0);
    ASTORE((it + 1) & 1)
    __builtin_amdgcn_sched_barrier(0);
    ALOAD(min(it + 2, ntiles - 1))
    __builtin_amdgcn_sched_barrier(0);
    int mxb = __float_as_int(s[0][0][0]);
#pragma unroll
    for (int qn = 0; qn < 2; ++qn)
#pragma unroll
      for (int i = 0; i < 16; ++i) mxb = max(mxb, max(__float_as_int(s[qn][0][i]), __float_as_int(s[qn][1][i])));
    if (__any((it == 0) || (mxb > 0x41000000))) {
#pragma unroll
      for (int qn = 0; qn < 2; ++qn) {
        float mx = -1e30f;
#pragma unroll
        for (int i = 0; i < 16; ++i) mx = fmaxf(mx, fmaxf(s[qn][0][i], s[qn][1][i]));
        mx = fmaxf(mx, __shfl_xor(mx, 32, 64));
        const float delta = (it == 0) ? mx : fmaxf(mx, 0.f);
        const float alpha = (it == 0) ? 1.f : __builtin_amdgcn_exp2f(-delta);
        m[qn] += delta;
        lsum[qn] *= alpha;
#pragma unroll
        for (int i = 0; i < 16; ++i) { o[qn][0][i] *= alpha; o[qn][1][i] *= alpha; s[qn][0][i] -= delta; s[qn][1][i] -= delta; }
      }
    }
#pragma unroll
    for (int mt = 0; mt < 2; ++mt) {
#pragma unroll
      for (int qn = 0; qn < 2; ++qn) {
        float rsum = 0;
#pragma unroll
        for (int i = 0; i < 16; ++i) { s[qn][mt][i] = __builtin_amdgcn_exp2f(s[qn][mt][i]); rsum += s[qn][mt][i]; }
        lsum[qn] += rsum;
      }
#pragma unroll
      for (int sx = 0; sx < 2; ++sx) {
        const int base = mt * 32 + sx * 16 + 4 * h;
        union { bf16x8 v; uint2 u[2]; } va, vb;
        va.u[0] = *(const uint2*)(sV + r * VSTR + base);
        va.u[1] = *(const uint2*)(sV + r * VSTR + base + 8);
        vb.u[0] = *(const uint2*)(sV + (32 + r) * VSTR + base);
        vb.u[1] = *(const uint2*)(sV + (32 + r) * VSTR + base + 8);
#pragma unroll
        for (int qn = 0; qn < 2; ++qn) {
          union { bf16x8 v; unsigned u[4]; } pk;
          pk.u[0] = pack2(s[qn][mt][8 * sx + 0], s[qn][mt][8 * sx + 1]); pk.u[1] = pack2(s[qn][mt][8 * sx + 2], s[qn][mt][8 * sx + 3]);
          pk.u[2] = pack2(s[qn][mt][8 * sx + 4], s[qn][mt][8 * sx + 5]); pk.u[3] = pack2(s[qn][mt][8 * sx + 6], s[qn][mt][8 * sx + 7]);
          o[qn][0] = MFMA32(va.v, pk.v, o[qn][0]);
          o[qn][1] = MFMA32(vb.v, pk.v, o[qn][1]);
        }
      }
    }
  }
#undef ALOAD
#undef ASTORE
#pragma unroll
  for (int qn = 0; qn < 2; ++qn) {
    const float lt = lsum[qn] + __shfl_xor(lsum[qn], 32, 64);
    const float inv = 1.f / lt;
    bf16_t* yp = Y + ((size_t)b * TT + q0 + w * 64 + qn * 32 + r) * DM + ycol;
#pragma unroll
    for (int g = 0; g < 4; ++g) {
      uint2 u0, u1;
      u0.x = pack2(o[qn][0][4 * g] * inv, o[qn][0][4 * g + 1] * inv); u0.y = pack2(o[qn][0][4 * g + 2] * inv, o[qn][0][4 * g + 3] * inv);
      u1.x = pack2(o[qn][1][4 * g] * inv, o[qn][1][4 * g + 1] * inv); u1.y = pack2(o[qn][1][4 * g + 2] * inv, o[qn][1][4 * g + 3] * inv);
      *(uint2*)(yp + 8 * g + 4 * h) = u0;
      *(uint2*)(yp + 32 + 8 * g + 4 * h) = u1;
    }
  }
}

DI void phase_C(char* smem, const Params& p, int layer) {
  const int J_S5 = 16, J_HG = 256, J_SWA = NBATCH * 4 * 33;
  const int G = gridDim.x;
  for (int j = bid_(); j < J_S5; j += G) {
    const int gid = j * NTHR + tid_();
    const int pp = gid & 63, dirn = (gid >> 6) & 1, g = (gid >> 7) & 15, b = gid >> 11;
    const int jb = (layer * 2 + dirn) * 16 + g;
    const float ar = p.apow[((size_t)jb * 33 + 32) * 128 + pp * 2], ai = p.apow[((size_t)jb * 33 + 32) * 128 + pp * 2 + 1];
    float sr = 0, si = 0;
    float* base = p.Es5 + ((size_t)b * NCH * 16 + g) * 256 + dirn * 128 + pp * 2;
#define MCH(n) (dirn == 0 ? (n) : ((n) < 8 ? 7 - (n) : 271 - (n)))
#pragma unroll 1
    for (int n0 = 0; n0 < NCH; n0 += 44) {
      float2 e[44];
#pragma unroll
      for (int u = 0; u < 44; ++u) e[u] = *(const float2*)(base + (size_t)MCH(n0 + u) * 4096);
#pragma unroll
      for (int u = 0; u < 44; ++u) {
        *(float2*)(base + (size_t)MCH(n0 + u) * 4096) = make_float2(sr, si);
        const float nr = ar * sr - ai * si + e[u].x, ni = ar * si + ai * sr + e[u].y;
        sr = nr; si = ni;
      }
    }
#undef MCH
  }
  for (int j = bid_(); j < J_HG; j += G) {
    const int gid = j * NTHR + tid_();
    const int chain = gid >> 12, e = gid & 4095, d = e & 63;
    float* base = p.Eh + (size_t)chain * NSC * 4096 + e;
    const float* db = p.dech + (size_t)chain * NSC * 64 + d;
    float s = 0;
#pragma unroll 1
    for (int n0 = 0; n0 < NSC; n0 += 22) {
      float ev[22], dv[22];
#pragma unroll
      for (int u = 0; u < 22; ++u) { ev[u] = base[(size_t)(n0 + u) * 4096]; dv[u] = db[(n0 + u) * 64]; }
#pragma unroll
      for (int u = 0; u < 22; ++u) { base[(size_t)(n0 + u) * 4096] = s; s = dv[u] * s + ev[u]; }
    }
  }
  {
    const int nb = G > 32 ? G - 16 : G, me = G > 32 ? bid_() - 16 : bid_();
    if (me >= 0) {
      for (int j = me; j < J_SWA; j += nb) {
        const int qt = j % 33, bh = j / 33, hd = bh & 3, b = bh >> 2;
        attn_item<64, true>(smem, p.Qs, p.Ks, p.VsT, b * 4 + hd, b * 2 + (hd >> 1), b, qt * 256, true,
                            p.sink[layer * 4 + hd] * LOG2E, p.Hn, 256 + hd * 64);
      }
    }
  }
}

DI void phase_D(char* smem, const Params& p, int layer) {
  const int J_MLA = 256 + 16, J_RD = 16 * 5 * 2, J_HG = NBATCH * 4 * 2 * NSC / 2;
  const int G = gridDim.x;
  for (int j = bid_(); j < J_MLA; j += G) {
    if (j < 256) {
      const int rest = j >> 3, bh = (j & 7) + 8 * (rest >> 4), qt = rest & 15;
      attn_item2<96>(smem, p.Qm, p.Km, p.VmT, bh, bh, bh >> 2, CTXL + qt * 512, p.Hn, 768 + (bh & 3) * 64);
    } else {
      const int bh = j - 256;
      attn_item<96, false>(smem, p.Qm, p.Km, p.VmT, bh, bh, bh >> 2, 0, false, 0.f, p.Hn, 768 + (bh & 3) * 64);
    }
  }
  for (int j = (bid_() + G - (J_MLA % G)) % G; j < J_RD; j += G) {
    const int g = j / 10, q = j % 10, mt = q >> 1, nt = q & 1;
    const bf16_t* Pu = p.Pu; const float* Es = p.Es5;
    auto al = [=](int row, int k) -> uint4 {
      row = min(row, NCHR - 1);
      if (k < 512) return *(const uint4*)(Pu + ((size_t)row * 32 + (k >> 4)) * 256 + g * 16 + (k & 15));
      const float* e = Es + ((size_t)row * 16 + g) * 256 + (k - 512);
      float4 a = *(const float4*)e, c = *(const float4*)(e + 4);
      return make_uint4(pack2(a.x, a.y), pack2(a.z, a.w), pack2(c.x, c.y), pack2(c.z, c.w));
    };
    bf16_t* Yg = p.Yg;
    auto ep = [=](int row, int col, float v0, float v1, float v2, float v3) {
      if (row >= NCHR) return;
      const int t = col >> 4, hh = col & 15;
      auto gelu = [](float v) {
        const float u = 0.7978845608028654f * (v + 0.044715f * v * v * v);
        const float th = 1.f - 2.f * __builtin_amdgcn_rcpf(1.f + __expf(2.f * u));
        return 0.5f * v * (1.f + th);
      };
      *(uint2*)(Yg + ((size_t)row * 32 + t) * 256 + g * 16 + hh) = make_uint2(pack2(gelu(v0), gelu(v1)), pack2(gelu(v2), gelu(v3)));
    };
    gemm_tile(smem, al, p.TW + (size_t)(layer * 16 + g) * 512 * 768, 768, 512, ep, mt * 256, nt * 256, 768);
  }
  for (int j = (bid_() + G - ((J_MLA + J_RD) % G)) % G; j < J_HG; j += G) hg_item<true>(smem, p, layer, j);
}

DI void phase_E(char* smem, const Params& p, int layer) {
  const int J_GLU = 132, J_FIN = R / 16;
  const int G = gridDim.x;
  for (int j = bid_(); j < J_GLU; j += G) {
    const int mt = j, nt = 0;
    const bf16_t* Yg = p.Yg; bf16_t* Hn = p.Hn; const float* bg = p.b_glu + layer * 256;
    auto al = [=](int row, int k) -> uint4 { return *(const uint4*)(Yg + (size_t)row * 256 + k); };
    auto ep = [=](int row, int col, float v0, float v1, float v2, float v3) {
      const uint2 yy = *(const uint2*)(Yg + (size_t)row * 256 + col);
      const float4 bb = *(const float4*)(bg + col);
      const float y0 = __uint_as_float(yy.x << 16), y1 = __uint_as_float(yy.x & 0xffff0000u);
      const float y2 = __uint_as_float(yy.y << 16), y3 = __uint_as_float(yy.y & 0xffff0000u);
      *(uint2*)(Hn + (size_t)row * DM + col) = make_uint2(pack2(y0 * fsigmoid(v0 + bb.x), y1 * fsigmoid(v1 + bb.y)),
                                                         pack2(y2 * fsigmoid(v2 + bb.z), y3 * fsigmoid(v3 + bb.w)));
    };
    gemm_tile_dma<4>(smem, p.Yg, 256, p.Wg + (size_t)layer * 65536, 256, 256, ep, mt * 256, nt * 256, 256);
  }
  for (int j = (bid_() + G - (J_GLU % G)) % G; j < J_FIN; j += G) {
    const int w = (tid_() >> 6) & 3, rsel = tid_() >> 8, l = tid_() & 63;
    const float gn = p.hg_norm_g[layer * 64 + l];
#pragma unroll
    for (int rr = 0; rr < 8; ++rr) {
      const int row = j * 16 + rr * 2 + rsel;
      const float o = bf2f(p.OF[(size_t)row * 256 + w * 64 + l]) + bf2f(p.OB[(size_t)row * 256 + w * 64 + l]);
      const float ss = wave_sum(o * o);
      const float rs = rsqrtf(ss * (1.f / 64.f) + EPSN);
      const float gt = bf2f(p.PH[(size_t)row * 1280 + 1024 + w * 64 + l]);
      p.Hn[(size_t)row * DM + 512 + w * 64 + l] = f2bf(o * rs * gn * gt * sigmoidf_(gt));
    }
  }
}

DI void phase_resid(char* smem, const Params& p, int layer, const bf16_t* A, int K, const bf16_t* W, int gate_idx, bool first) {
  auto al = [=](int row, int k) -> uint4 { return *(const uint4*)(A + (size_t)row * K + k); };
  auto ep = [&](int row, int col, float v0, float v1, float v2, float v3) {
    const int b = row / TT, t = row - b * TT;
    const float4 g = *(const float4*)(p.mod + (size_t)(layer * 5 + (t < CTXL ? 4 : b)) * 6144 + gate_idx * 1024 + col);
    const float4 xo = *(const float4*)(xsrc_row(p, first, row) + col);
    *(float4*)(xdst_row(p, row) + col) = make_float4(xo.x + g.x * v0, xo.y + g.y * v1, xo.z + g.z * v2, xo.w + g.w * v3);
  };
  for_tiles_xcd<1>(R / 256, 4, [&](int m0, int nt, auto mi) { gemm_tile_dma<decltype(mi)::value>(smem, A, K, W, K, DM, ep, m0, nt * 256, K); });
}

DI void phase_ffn_up(char* smem, const Params& p, int layer) {
  const bf16_t* Hn = p.Hn;
  auto al = [=](int row, int k) -> uint4 { return *(const uint4*)(Hn + (size_t)row * DM + k); };
  bf16_t* Hh = p.H;
  auto ep = [=](int row, int cb, int q4, const f32x4& c0, const f32x4& c1, const f32x4& c2, const f32x4& c3) {
    const uint4 o = make_uint4(pack2(c0[0] * fsigmoid(c0[0]) * c0[1], c0[2] * fsigmoid(c0[2]) * c0[3]),
                               pack2(c1[0] * fsigmoid(c1[0]) * c1[1], c1[2] * fsigmoid(c1[2]) * c1[3]),
                               pack2(c2[0] * fsigmoid(c2[0]) * c2[1], c2[2] * fsigmoid(c2[2]) * c2[3]),
                               pack2(c3[0] * fsigmoid(c3[0]) * c3[1], c3[2] * fsigmoid(c3[2]) * c3[3]));
    *(uint4*)(Hh + (size_t)row * FH + (cb >> 1) + q4 * 8) = o;
  };
  const bf16_t* W = p.Wu + (size_t)layer * 2 * FH * DM;
  for_tiles_xcd<2>(R / 256, 22, [&](int m0, int nt, auto mi) { gemm_tile_dma<decltype(mi)::value>(smem, Hn, DM, W, DM, 2 * FH, ep, m0, nt * 256, DM); });
}

constexpr int N_PHASES = 2 + 10 * DEPTH;

__global__ void __launch_bounds__(512, 2) mega(Params p, int ph_lo, int ph_hi) {
  extern __shared__ __attribute__((aligned(16))) char smem[];
  for (int ph = ph_lo; ph < ph_hi; ++ph) {
    if (ph == 0) phase_prep(smem, p);
    else if (ph == 1) { phase_s5mats(p); phase_norm(p, 0, 0, true); }
    else {
      const int layer = (ph - 2) / 10, s = (ph - 2) % 10;
      const bool first = layer == 0;
      switch (s) {
        case 0: phase_win(smem, p, layer); break;
        case 1: phase_B(smem, p, layer); break;
        case 2: phase_C(smem, p, layer); break;
        case 3: phase_D(smem, p, layer); break;
        case 4: phase_E(smem, p, layer); break;
        case 5: phase_resid(smem, p, layer, p.Hn, DM, p.Wo + (size_t)layer * DM * DM, 2, first); break;
        case 6: phase_norm(p, layer, 1, false); break;
        case 7: phase_ffn_up(smem, p, layer); break;
        case 8: phase_resid(smem, p, layer, p.H, FH, p.Wd + (size_t)layer * DM * FH, 5, false); break;
        default:
          if (layer + 1 < DEPTH) phase_norm(p, layer + 1, 0, false); else phase_final_norm(p);
          break;
      }
    }
    if (ph + 1 < ph_hi) grid_barrier(p.bar, (unsigned)(ph - ph_lo + 1));
  }
}

extern "C" void kernel_launch(void* const* d_in, const int* in_sizes, int n_in, void* d_out, int out_size, void* d_ws,
                              size_t ws_size, hipStream_t stream) {
  static int grid_blocks = 0;
  if (!grid_blocks) {
    int dev = 0, cus = 0, per_cu = 0;
    hipGetDevice(&dev);
    hipDeviceGetAttribute(&cus, hipDeviceAttributeMultiprocessorCount, dev);
    hipFuncSetAttribute((const void*)mega, hipFuncAttributeMaxDynamicSharedMemorySize, LDS_BYTES);
    hipOccupancyMaxActiveBlocksPerMultiprocessor(&per_cu, (const void*)mega, NTHR, LDS_BYTES);
    (void)per_cu;
    grid_blocks = cus;
  }
  Params p{};
  const float** ins = (const float**)&p;
  for (int i = 0; i < 30; ++i) ins[i] = (const float*)d_in[i];
  p.out = (float*)d_out;
  char* ws = (char*)d_ws;
  size_t off = 0;
  auto take = [&](size_t bytes) { char* q = ws + off; off += (bytes + 255) & ~(size_t)255; return q; };
  p.bar = (unsigned*)take(8192);
  p.Xc = (float*)take((size_t)NBATCH * CTXL * DM * 4);
  p.mod = (float*)take((size_t)DEPTH * 5 * 6144 * 4);
  p.lb = (float*)take(2 * 4 * 256 * 4);
  p.ropeS = (float*)take(128 * 16 * 2 * 4);
  p.ropeM = (float*)take(128 * 8 * 2 * 4);
  p.apow = (float*)take((size_t)J_S5TAB * 33 * 128 * 4);
  p.bbar = (float*)take((size_t)J_S5TAB * 64 * 16 * 2 * 4);
  p.Ktab = (float*)take((size_t)J_S5TAB * 32 * 256 * 4);
  p.Wi = (bf16_t*)take((size_t)DEPTH * NINP * DM * 2);
  p.Wo = (bf16_t*)take((size_t)DEPTH * DM * DM * 2);
  p.Wu = (bf16_t*)take((size_t)DEPTH * 2 * FH * DM * 2);
  p.Wd = (bf16_t*)take((size_t)DEPTH * DM * FH * 2);
  p.Wg = (bf16_t*)take((size_t)DEPTH * 65536 * 2);
  p.Wq = (bf16_t*)take((size_t)DEPTH * 384 * 256 * 2);
  p.Wkv = (bf16_t*)take((size_t)DEPTH * 512 * 128 * 2);
  p.TW = (bf16_t*)take((size_t)DEPTH * 16 * 512 * 768 * 2);
  p.W1 = (bf16_t*)take((size_t)DEPTH * 16 * 256 * 512 * 2);
  p.Hn = (bf16_t*)take((size_t)R * DM * 2);
  const size_t big0 = off;
  p.Pu = (bf16_t*)take((size_t)R * 256 * 2);
  p.PH = (bf16_t*)take((size_t)R * 1280 * 2);
  p.Es5 = (float*)take((size_t)NCHR * 16 * 256 * 4);
  p.Eh = (float*)take((size_t)NBATCH * 4 * 2 * NSC * 4096 * 4);
  p.dech = (float*)take((size_t)NBATCH * 4 * 2 * NSC * 64 * 4);
  p.Qm = (bf16_t*)take((size_t)R * 4 * 96 * 2);
  p.Km = (bf16_t*)take((size_t)R * 4 * 96 * 2);
  p.VmT = (bf16_t*)take((size_t)R * 256 * 2);
  const size_t al0 = off;
  p.Pm = (bf16_t*)take((size_t)R * 384 * 2);
  p.Qs = (bf16_t*)take((size_t)R * 256 * 2);
  p.Ks = (bf16_t*)take((size_t)R * 128 * 2);
  p.VsT = (bf16_t*)take((size_t)R * 128 * 2);
  const size_t end1 = off;
  off = al0;
  p.Yg = (bf16_t*)take((size_t)R * 256 * 2);
  p.OF = (bf16_t*)take((size_t)R * 256 * 2);
  p.OB = (bf16_t*)take((size_t)R * 256 * 2);
  size_t end2 = off;
  p.H = (bf16_t*)(ws + big0);
  size_t endH = big0 + (size_t)R * FH * 2;
  size_t total = end1 > end2 ? end1 : end2;
  if (endH > total) total = endH;
  if (total > ws_size) { fprintf(stderr, "kernel_launch: workspace too small: need %zu, have %zu\n", total, ws_size); return; }
  if (hipMemsetAsync(p.bar, 0, 8192, stream) != hipSuccess) { fprintf(stderr, "memset failed\n"); return; }
  int lo = 0, hi = N_PHASES;
  void* args[] = {&p, &lo, &hi};
  hipError_t e = hipLaunchCooperativeKernel((const void*)mega, dim3(grid_blocks), dim3(NTHR), args, LDS_BYTES, stream);
  if (e != hipSuccess) fprintf(stderr, "cooperative launch failed: %s (grid %d)\n", hipGetErrorString(e), grid_blocks);
}
```
